# Optimizing an MI355X kernel written in HIP

```python
import jax, jax.numpy as jnp
from jax import lax
import numpy as np

D_MODEL = 1024
BATCH = 4
SEQ = 8192
DEPTH = 1

D_MIX = D_MODEL
ATTN_HEADS = 8
HEAD_DIM = 64
D_ATTN = ATTN_HEADS * HEAD_DIM
CONV_GROUPS = 8
D_CONV = D_MIX - D_ATTN
CONV_WIDTH = 3
IDX_HEADS = 8
IDX_DIM = 64
MAX_TOPK = 256
Q_BLOCK = 128
PEER_HEADS = 8
PEER_KEYS = 128
PEER_EXPERTS = PEER_KEYS * PEER_KEYS
PEER_HALF = 128
PEER_QDIM = 2 * PEER_HALF
PEER_TOPK = 16
EPS = 1e-6

SPLITS = [D_ATTN, D_ATTN, D_ATTN, D_CONV, D_CONV, D_CONV, IDX_HEADS * IDX_DIM, IDX_DIM, IDX_HEADS]
D_IN = sum(SPLITS)

kernel_name = "hybrid_dsa_shortconv_peer_block"


def rms_norm(x, w):
    xf = x.astype(jnp.float32)
    y = xf * lax.rsqrt(jnp.mean(xf * xf, axis=-1, keepdims=True) + EPS)
    return (y * w.astype(jnp.float32)).astype(x.dtype)


def _gather_rows(t, idx):
    return jax.vmap(lambda tb, ib: tb[ib])(t, idx)


def dsa_attention(q, k, v, iq, ik, iw):
    B, L = q.shape[0], q.shape[1]
    topk = min(MAX_TOPK, L // 4)
    n_blocks = L // Q_BLOCK
    s_pos = jnp.arange(L)
    att_scale = HEAD_DIM ** -0.5
    idx_scale = (IDX_DIM ** -0.5) * (IDX_HEADS ** -0.5)

    def block_fn(blk):
        start = blk * Q_BLOCK
        qb = lax.dynamic_slice_in_dim(q, start, Q_BLOCK, axis=1)
        iqb = lax.dynamic_slice_in_dim(iq, start, Q_BLOCK, axis=1)
        iwb = lax.dynamic_slice_in_dim(iw, start, Q_BLOCK, axis=1)
        t_pos = start + jnp.arange(Q_BLOCK)
        rel = jax.nn.relu(jnp.einsum('bqhd,bsd->bqhs', iqb, ik).astype(jnp.float32))
        score = jnp.einsum('bqhs,bqh->bqs', rel, iwb.astype(jnp.float32)) * idx_scale
        causal = s_pos[None, None, :] <= t_pos[None, :, None]
        score = jnp.where(causal, score, -jnp.inf)
        _, sel = lax.top_k(score, topk)
        k_sel = _gather_rows(k, sel)
        v_sel = _gather_rows(v, sel)
        logits = jnp.einsum('bqhd,bqkhd->bhqk', qb, k_sel).astype(jnp.float32) * att_scale
        valid = (sel <= t_pos[None, :, None])[:, None, :, :]
        logits = jnp.where(valid, logits, -jnp.inf)
        p = jax.nn.softmax(logits, axis=-1).astype(v.dtype)
        o = jnp.einsum('bhqk,bqkhd->bqhd', p, v_sel)
        return o.reshape(B, Q_BLOCK, ATTN_HEADS * HEAD_DIM)

    out = lax.map(block_fn, jnp.arange(n_blocks))
    return out.transpose(1, 0, 2, 3).reshape(B, L, ATTN_HEADS * HEAD_DIM)


def short_conv(b_gate, c_gate, xc, conv_w, conv_b):
    L = xc.shape[1]
    u = c_gate * xc
    up = jnp.pad(u, ((0, 0), (CONV_WIDTH - 1, 0), (0, 0)))
    y = conv_b
    for j in range(CONV_WIDTH):
        y = y + conv_w[j] * up[:, j:j + L]
    return b_gate * y


def peer_ffn(h, peer_wq, peer_subkeys, peer_u, peer_v):
    B, L, D = h.shape
    n_blocks = L // Q_BLOCK
    hb_all = h.reshape(B, n_blocks, Q_BLOCK, D).transpose(1, 0, 2, 3)

    def block_fn(hb):
        q = (hb @ peer_wq).reshape(B, Q_BLOCK, PEER_HEADS, 2, PEER_HALF)
        s = jnp.einsum('bqhpd,hpnd->bqhpn', q, peer_subkeys).astype(jnp.float32)
        vals, idx = lax.top_k(s, PEER_TOPK)
        combo = vals[..., 0, :, None] + vals[..., 1, None, :]
        ids = idx[..., 0, :, None] * PEER_KEYS + idx[..., 1, None, :]
        combo = combo.reshape(B, Q_BLOCK, PEER_HEADS, PEER_TOPK * PEER_TOPK)
        ids = ids.reshape(B, Q_BLOCK, PEER_HEADS, PEER_TOPK * PEER_TOPK)
        top_s, pos = lax.top_k(combo, PEER_TOPK)
        expert = jnp.take_along_axis(ids, pos, axis=-1)
        g = jax.nn.softmax(top_s, axis=-1).astype(hb.dtype)
        u_sel = peer_u[expert]
        a = jax.nn.gelu(jnp.einsum('bqhkd,bqd->bqhk', u_sel, hb))
        v_sel = peer_v[expert]
        return jnp.einsum('bqhk,bqhkd->bqd', g * a, v_sel)

    out = lax.map(block_fn, hb_all)
    return out.transpose(1, 0, 2, 3).reshape(B, L, D)


def setup_inputs(seed: int = 0) -> dict:
    key = jax.random.key(seed)
    ks = jax.random.split(key, 20)
    f32 = jnp.float32
    nrm = lambda k, shape, s: jax.random.normal(k, shape, f32) * s
    return {
        "x": nrm(ks[0], (BATCH, SEQ, D_MODEL), 1.0),
        "c": nrm(ks[1], (BATCH, D_MODEL), 1.0),
        "norm1_w": 1.0 + nrm(ks[2], (D_MODEL,), 0.02),
        "norm2_w": 1.0 + nrm(ks[3], (D_MODEL,), 0.02),
        "w_ada": nrm(ks[4], (D_MODEL, 6 * D_MODEL), D_MODEL ** -0.5),
        "b_ada": nrm(ks[5], (6 * D_MODEL,), 0.02),
        "w_in": nrm(ks[6], (D_MODEL, D_IN), D_MODEL ** -0.5),
        "q_norm_w": 1.0 + nrm(ks[7], (HEAD_DIM,), 0.02),
        "k_norm_w": 1.0 + nrm(ks[8], (HEAD_DIM,), 0.02),
        "conv_w": nrm(ks[9], (CONV_WIDTH, D_CONV), CONV_WIDTH ** -0.5),
        "conv_b": nrm(ks[10], (D_CONV,), 0.01),
        "attn_out_norm_w": 1.0 + nrm(ks[11], (D_ATTN,), 0.02),
        "conv_out_norm_w": 1.0 + nrm(ks[12], (D_CONV,), 0.02),
        "w_out": nrm(ks[13], (D_MIX, D_MODEL), D_MIX ** -0.5),
        "peer_wq": nrm(ks[14], (D_MODEL, PEER_HEADS * PEER_QDIM), D_MODEL ** -0.5),
        "peer_subkeys": nrm(ks[15], (PEER_HEADS, 2, PEER_KEYS, PEER_HALF), PEER_HALF ** -0.5),
        "peer_u": nrm(ks[16], (PEER_EXPERTS, D_MODEL), D_MODEL ** -0.5),
        "peer_v": nrm(ks[17], (PEER_EXPERTS, D_MODEL), PEER_HEADS ** -0.5),
    }


def reference(x, c, norm1_w, norm2_w, w_ada, b_ada, w_in, q_norm_w, k_norm_w,
              conv_w, conv_b, attn_out_norm_w, conv_out_norm_w, w_out,
              peer_wq, peer_subkeys, peer_u, peer_v):
    B, L, _ = x.shape
    mod = jax.nn.silu(c) @ w_ada + b_ada
    shift1, scale1, gate1, shift2, scale2, gate2 = [m[:, None, :] for m in jnp.split(mod, 6, axis=-1)]

    for _ in range(DEPTH):
        h = rms_norm(x, norm1_w) * (1.0 + scale1) + shift1
        proj = h @ w_in
        offs = np.cumsum(SPLITS)[:-1].tolist()
        q, k, v, cb, cc, cx, iq, ik, iw = jnp.split(proj, offs, axis=-1)
        q = rms_norm(q.reshape(B, L, ATTN_HEADS, HEAD_DIM), q_norm_w)
        k = rms_norm(k.reshape(B, L, ATTN_HEADS, HEAD_DIM), k_norm_w)
        v = v.reshape(B, L, ATTN_HEADS, HEAD_DIM)
        iq = iq.reshape(B, L, IDX_HEADS, IDX_DIM)
        y_attn = dsa_attention(q, k, v, iq, ik, iw)
        y_conv = short_conv(cb, cc, cx, conv_w, conv_b)
        y_mix = jnp.concatenate([rms_norm(y_attn, attn_out_norm_w),
                                 rms_norm(y_conv, conv_out_norm_w)], axis=-1)
        x = x + gate1 * (y_mix @ w_out)
        h2 = rms_norm(x, norm2_w) * (1.0 + scale2) + shift2
        x = x + gate2 * peer_ffn(h2, peer_wq, peer_subkeys, peer_u, peer_v)
    return x
```

```cpp
#include <hip/hip_runtime.h>
#include <hip/hip_fp16.h>
#include <stdint.h>

typedef _Float16 half_t;
typedef _Float16 half8 __attribute__((ext_vector_type(8)));
typedef _Float16 half4 __attribute__((ext_vector_type(4)));
typedef float f32x4 __attribute__((ext_vector_type(4)));
typedef float f32x16 __attribute__((ext_vector_type(16)));
typedef unsigned int u32x4 __attribute__((ext_vector_type(4)));

#define T_TOK 32768
#define SEQ 8192
#define NBATCH 4
#define DM 1024
#define DIN 3656
#define DINP 3712
#define NEG_INF (-__builtin_huge_valf())

struct Params {
  const float *x, *c, *norm1_w, *norm2_w, *w_ada, *b_ada, *w_in, *q_norm_w, *k_norm_w, *conv_w, *conv_b,
      *attn_out_norm_w, *conv_out_norm_w, *w_out, *peer_wq, *peer_subkeys, *peer_u, *peer_v;
  float* out;
  float* mod;
  half_t *wt_in, *wt_out, *wt_p, *pu, *pv;
  half_t *h, *q, *k, *v, *vt, *cb, *uu, *iq, *ik;
  float* iw;
  uint32_t* mask;
  half_t *yattn, *ymix, *h2, *ps;
};

__device__ __forceinline__ float wave_sum(float v) {
#pragma unroll
  for (int o = 32; o >= 1; o >>= 1) v += __shfl_xor(v, o);
  return v;
}
__device__ __forceinline__ int wave_sum_i(int v) {
#pragma unroll
  for (int o = 32; o >= 1; o >>= 1) v += __shfl_xor(v, o);
  return v;
}
__device__ __forceinline__ float wave_max(float v) {
#pragma unroll
  for (int o = 32; o >= 1; o >>= 1) v = fmaxf(v, __shfl_xor(v, o));
  return v;
}

__device__ __forceinline__ void prep_ada(const Params& p, float* sm, int bid, int nblk) {
  float* s_silu = sm;
  float* red = sm + 4096;
  const int tid = threadIdx.x;
  for (int i = tid; i < 4096; i += 256) {
    float cv = p.c[i];
    s_silu[i] = cv / (1.f + __expf(-cv));
  }
  __syncthreads();
  for (int tile = bid; tile < 96; tile += nblk) {
    const int j = tile * 64 + (tid & 63);
    const int ks = tid >> 6;
    float a0 = 0, a1 = 0, a2 = 0, a3 = 0;
    for (int k = ks * 256; k < ks * 256 + 256; ++k) {
      float w = p.w_ada[(size_t)k * 6144 + j];
      a0 += s_silu[k] * w;
      a1 += s_silu[1024 + k] * w;
      a2 += s_silu[2048 + k] * w;
      a3 += s_silu[3072 + k] * w;
    }
    red[(ks * 4 + 0) * 64 + (tid & 63)] = a0;
    red[(ks * 4 + 1) * 64 + (tid & 63)] = a1;
    red[(ks * 4 + 2) * 64 + (tid & 63)] = a2;
    red[(ks * 4 + 3) * 64 + (tid & 63)] = a3;
    __syncthreads();
    if (tid < 256) {
      const int b = tid >> 6, jj = tid & 63;
      float s = red[(0 * 4 + b) * 64 + jj] + red[(1 * 4 + b) * 64 + jj] + red[(2 * 4 + b) * 64 + jj] +
                red[(3 * 4 + b) * 64 + jj];
      p.mod[b * 6144 + tile * 64 + jj] = s + p.b_ada[tile * 64 + jj];
    }
    __syncthreads();
  }
}

__device__ __forceinline__ int perm_in_col(int n) {
  if (n >= 2048 && n < 3072) {
    int g = (n - 2048) >> 6, jj = (n - 2048) & 63;
    return (jj < 32) ? (2048 + g * 32 + jj) : (2560 + g * 32 + (jj - 32));
  }
  return n;
}

template <bool PERM>
__device__ __forceinline__ void prep_transpose(const float* __restrict__ src, half_t* __restrict__ dst, int N, int Npad, float* sm,
                               int bid, int nblk) {
  const int tid = threadIdx.x;
  const int ntn = Npad / 64;
  for (int tile = bid; tile < ntn * 16; tile += nblk) {
    const int nt = tile / 16, kt = tile % 16;
    const int n0 = nt * 64, k0 = kt * 64;
#pragma unroll 4
    for (int i = 0; i < 16; ++i) {
      int kk = i * 4 + (tid >> 6), nn = tid & 63;
      int n = n0 + nn;
      float v = 0.f;
      if (n < N) {
        int col = PERM ? perm_in_col(n) : n;
        v = src[(size_t)(k0 + kk) * N + col];
      }
      sm[kk * 65 + nn] = v;
    }
    __syncthreads();
#pragma unroll 4
    for (int i = 0; i < 16; ++i) {
      int nn = i * 4 + (tid >> 6), kk = tid & 63;
      dst[(size_t)(n0 + nn) * 1024 + k0 + kk] = (half_t)sm[kk * 65 + nn];
    }
    __syncthreads();
  }
}

__device__ __forceinline__ void prep_wprime(const Params& p, float* sm, int bid, int nblk) {
  float* sA = sm;
  float* sB = sm + 64 * 129;
  const int tid = threadIdx.x;
  for (int tile = bid; tile < 512; tile += nblk) {
    const int hp = tile >> 5, nt = (tile >> 4) & 1, kt = tile & 15;
    const int n0 = nt * 64, k0 = kt * 64;
    for (int i = tid; i < 64 * 128; i += 256) {
      int r = i >> 7, d = i & 127;
      sA[r * 129 + d] = p.peer_subkeys[((size_t)(hp * 128 + n0 + r)) * 128 + d];
      sB[r * 129 + d] = p.peer_wq[(size_t)(k0 + r) * 2048 + hp * 128 + d];
    }
    __syncthreads();
    const int tn = tid >> 4, tk = tid & 15;
    float acc[4][4];
#pragma unroll
    for (int a = 0; a < 4; ++a)
#pragma unroll
      for (int b = 0; b < 4; ++b) acc[a][b] = 0.f;
    for (int d = 0; d < 128; ++d) {
      float av[4], bv[4];
#pragma unroll
      for (int a = 0; a < 4; ++a) av[a] = sA[(tn * 4 + a) * 129 + d];
#pragma unroll
      for (int b = 0; b < 4; ++b) bv[b] = sB[(tk * 4 + b) * 129 + d];
#pragma unroll
      for (int a = 0; a < 4; ++a)
#pragma unroll
        for (int b = 0; b < 4; ++b) acc[a][b] += av[a] * bv[b];
    }
#pragma unroll
    for (int a = 0; a < 4; ++a)
#pragma unroll
      for (int b = 0; b < 4; ++b)
        p.wt_p[(size_t)(hp * 128 + n0 + tn * 4 + a) * 1024 + k0 + tk * 4 + b] = (half_t)acc[a][b];
    __syncthreads();
  }
}

__device__ __forceinline__ void prep_tables(const Params& p, int bid, int nblk) {
  const size_t nquad = (size_t)16384 * 1024 / 4;
  for (size_t i = (size_t)bid * 256 + threadIdx.x; i < nquad; i += (size_t)nblk * 256) {
    float4 a = ((const float4*)p.peer_u)[i];
    float4 b = ((const float4*)p.peer_v)[i];
    half4 ha = {(half_t)a.x, (half_t)a.y, (half_t)a.z, (half_t)a.w};
    half4 hb = {(half_t)b.x, (half_t)b.y, (half_t)b.z, (half_t)b.w};
    ((half4*)p.pu)[i] = ha;
    ((half4*)p.pv)[i] = hb;
  }
}

__device__ __forceinline__ void phase_norm_mod(const float* __restrict__ xin, const float* __restrict__ nw,
                               const float* __restrict__ mod, int shift_off, int scale_off,
                               half_t* __restrict__ hout, int bid, int nblk) {
  const int lane = threadIdx.x & 63, wave = threadIdx.x >> 6;
  for (int tok = bid * 4 + wave; tok < T_TOK; tok += nblk * 4) {
    const int b = tok >> 13;
    const float4* xr = (const float4*)(xin + (size_t)tok * 1024);
    float4 v[4];
    float ss = 0.f;
#pragma unroll
    for (int c = 0; c < 4; ++c) {
      v[c] = xr[c * 64 + lane];
      ss += v[c].x * v[c].x + v[c].y * v[c].y + v[c].z * v[c].z + v[c].w * v[c].w;
    }
    ss = wave_sum(ss);
    const float rs = rsqrtf(ss * (1.f / 1024.f) + 1e-6f);
#pragma unroll
    for (int c = 0; c < 4; ++c) {
      const int e = c * 256 + lane * 4;
      float4 w = *(const float4*)(nw + e);
      float4 sc = *(const float4*)(mod + b * 6144 + scale_off + e);
      float4 sh = *(const float4*)(mod + b * 6144 + shift_off + e);
      half4 o;
      o[0] = (half_t)(v[c].x * rs * w.x * (1.f + sc.x) + sh.x);
      o[1] = (half_t)(v[c].y * rs * w.y * (1.f + sc.y) + sh.y);
      o[2] = (half_t)(v[c].z * rs * w.z * (1.f + sc.z) + sh.z);
      o[3] = (half_t)(v[c].w * rs * w.w * (1.f + sc.w) + sh.w);
      *(half4*)(hout + (size_t)tok * 1024 + e) = o;
    }
  }
}

template <class Epi>
__device__ __forceinline__ void gemm_tile(const half_t* __restrict__ A, const half_t* __restrict__ Bt, int K, int m0,
                                          int n0, half_t* sA, half_t* sB, const Epi& epi) {
  const int tid = threadIdx.x, lane = tid & 63, wave = tid >> 6;
  const int wm = wave >> 1, wn = wave & 1;
  const int l15 = lane & 15, quad = lane >> 4;
  f32x4 acc[4][4];
#pragma unroll
  for (int i = 0; i < 4; ++i)
#pragma unroll
    for (int j = 0; j < 4; ++j) acc[i][j] = (f32x4){0.f, 0.f, 0.f, 0.f};
  u32x4 ra[4], rb[4];
  const int nk = K >> 6;
  const half_t* Ap = A + (size_t)m0 * K;
  const half_t* Bp = Bt + (size_t)n0 * K;
#pragma unroll
  for (int i = 0; i < 4; ++i) {
    int c = tid + i * 256, row = c >> 3, kc = c & 7;
    ra[i] = *(const u32x4*)(Ap + (size_t)row * K + kc * 8);
    rb[i] = *(const u32x4*)(Bp + (size_t)row * K + kc * 8);
  }
  for (int kt = 0; kt < nk; ++kt) {
#pragma unroll
    for (int i = 0; i < 4; ++i) {
      int c = tid + i * 256, row = c >> 3, kc = c & 7;
      *(u32x4*)(sA + row * 72 + kc * 8) = ra[i];
      *(u32x4*)(sB + row * 72 + kc * 8) = rb[i];
    }
    __syncthreads();
    if (kt + 1 < nk) {
      const int k0 = (kt + 1) * 64;
#pragma unroll
      for (int i = 0; i < 4; ++i) {
        int c = tid + i * 256, row = c >> 3, kc = c & 7;
        ra[i] = *(const u32x4*)(Ap + (size_t)row * K + k0 + kc * 8);
        rb[i] = *(const u32x4*)(Bp + (size_t)row * K + k0 + kc * 8);
      }
    }
#pragma unroll
    for (int ks = 0; ks < 2; ++ks) {
      half8 af[4], bf[4];
#pragma unroll
      for (int i = 0; i < 4; ++i) af[i] = *(const half8*)(sA + (wm * 64 + i * 16 + l15) * 72 + ks * 32 + quad * 8);
#pragma unroll
      for (int j = 0; j < 4; ++j) bf[j] = *(const half8*)(sB + (wn * 64 + j * 16 + l15) * 72 + ks * 32 + quad * 8);
#pragma unroll
      for (int i = 0; i < 4; ++i)
#pragma unroll
        for (int j = 0; j < 4; ++j) acc[i][j] = __builtin_amdgcn_mfma_f32_16x16x32_f16(af[i], bf[j], acc[i][j], 0, 0, 0);
    }
    __syncthreads();
  }
  epi(acc, m0 + wm * 64, n0 + wn * 64, lane);
}

struct EpiIn {
  Params p;
  __device__ __forceinline__ void operator()(f32x4 (&acc)[4][4], int rb, int cb, int lane) const {
    const int l15 = lane & 15, quad = lane >> 4;
    if (cb < 1024) {
      const bool isq = cb < 512;
      const int hc = (cb & 511);
      const float* nw = isq ? p.q_norm_w : p.k_norm_w;
      half_t* dst = isq ? p.q : p.k;
      float w[4];
#pragma unroll
      for (int j = 0; j < 4; ++j) w[j] = nw[j * 16 + l15];
#pragma unroll
      for (int i = 0; i < 4; ++i)
#pragma unroll
        for (int r = 0; r < 4; ++r) {
          float ss = 0.f;
#pragma unroll
          for (int j = 0; j < 4; ++j) ss += acc[i][j][r] * acc[i][j][r];
          ss += __shfl_xor(ss, 1);
          ss += __shfl_xor(ss, 2);
          ss += __shfl_xor(ss, 4);
          ss += __shfl_xor(ss, 8);
          const float rs = rsqrtf(ss * (1.f / 64.f) + 1e-6f);
          const int row = rb + i * 16 + quad * 4 + r;
#pragma unroll
          for (int j = 0; j < 4; ++j) dst[(size_t)row * 512 + hc + j * 16 + l15] = (half_t)(acc[i][j][r] * rs * w[j]);
        }
    } else if (cb < 2048) {
      half_t* dst = (cb < 1536) ? p.v : p.cb;
      const int c0 = (cb < 1536) ? cb - 1024 : cb - 1536;
#pragma unroll
      for (int i = 0; i < 4; ++i)
#pragma unroll
        for (int r = 0; r < 4; ++r) {
          const int row = rb + i * 16 + quad * 4 + r;
#pragma unroll
          for (int j = 0; j < 4; ++j) dst[(size_t)row * 512 + c0 + j * 16 + l15] = (half_t)acc[i][j][r];
        }
    } else if (cb < 3072) {
      const int g = (cb - 2048) >> 6;
#pragma unroll
      for (int i = 0; i < 4; ++i)
#pragma unroll
        for (int r = 0; r < 4; ++r) {
          const int row = rb + i * 16 + quad * 4 + r;
#pragma unroll
          for (int j = 0; j < 2; ++j)
            p.uu[(size_t)row * 512 + g * 32 + j * 16 + l15] = (half_t)(acc[i][j][r] * acc[i][j + 2][r]);
        }
    } else if (cb < 3584) {
      const int c0 = cb - 3072;
#pragma unroll
      for (int i = 0; i < 4; ++i)
#pragma unroll
        for (int r = 0; r < 4; ++r) {
          const int row = rb + i * 16 + quad * 4 + r;
#pragma unroll
          for (int j = 0; j < 4; ++j) p.iq[(size_t)row * 512 + c0 + j * 16 + l15] = (half_t)acc[i][j][r];
        }
    } else if (cb == 3584) {
#pragma unroll
      for (int i = 0; i < 4; ++i)
#pragma unroll
        for (int r = 0; r < 4; ++r) {
          const int row = rb + i * 16 + quad * 4 + r;
#pragma unroll
          for (int j = 0; j < 4; ++j) p.ik[(size_t)row * 64 + j * 16 + l15] = (half_t)acc[i][j][r];
        }
    } else {
      if (l15 < 8) {
#pragma unroll
        for (int i = 0; i < 4; ++i)
#pragma unroll
          for (int r = 0; r < 4; ++r) {
            const int row = rb + i * 16 + quad * 4 + r;
            p.iw[(size_t)row * 8 + l15] = acc[i][0][r];
          }
      }
    }
  }
};

struct EpiOut {
  Params p;
  __device__ __forceinline__ void operator()(f32x4 (&acc)[4][4], int rb, int cb, int lane) const {
    const int l15 = lane & 15, quad = lane >> 4;
    const int b = rb >> 13;
    float g[4];
#pragma unroll
    for (int j = 0; j < 4; ++j) g[j] = p.mod[b * 6144 + 2048 + cb + j * 16 + l15];
#pragma unroll
    for (int i = 0; i < 4; ++i)
#pragma unroll
      for (int r = 0; r < 4; ++r) {
        const int row = rb + i * 16 + quad * 4 + r;
#pragma unroll
        for (int j = 0; j < 4; ++j) {
          const size_t idx = (size_t)row * 1024 + cb + j * 16 + l15;
          p.out[idx] = p.x[idx] + g[j] * acc[i][j][r];
        }
      }
  }
};

struct EpiPs {
  Params p;
  __device__ __forceinline__ void operator()(f32x4 (&acc)[4][4], int rb, int cb, int lane) const {
    const int l15 = lane & 15, quad = lane >> 4;
#pragma unroll
    for (int i = 0; i < 4; ++i)
#pragma unroll
      for (int r = 0; r < 4; ++r) {
        const int row = rb + i * 16 + quad * 4 + r;
#pragma unroll
        for (int j = 0; j < 4; ++j) p.ps[(size_t)row * 2048 + cb + j * 16 + l15] = (half_t)acc[i][j][r];
      }
  }
};

template <class Epi>
__device__ __forceinline__ void phase_gemm(const half_t* A, const half_t* Bt, int ntn, half_t* sm, const Epi& epi, int bid, int nblk) {
  const int ntiles = 256 * ntn;
  for (int t = bid; t < ntiles; t += nblk) {
    const int mt = t / ntn, nt = t % ntn;
    gemm_tile(A, Bt, 1024, mt * 128, nt * 128, sm, sm + 128 * 72, epi);
  }
}

__device__ __forceinline__ uint32_t fkey(float f) {
  uint32_t u = __float_as_uint(f);
  return (u & 0x80000000u) ? ~u : (u | 0x80000000u);
}

__device__ __forceinline__ void phase_index(const Params& p, float* sc, int bid, int nblk) {
  const int tid = threadIdx.x, lane = tid & 63, wave = tid >> 6;
  const int half = lane >> 5, l31 = lane & 31;
  const float idx_scale = 0.125f * 0.35355339059327373f;
  for (int task = bid; task < 8192; task += nblk) {
    const int pg = 2047 - (task >> 2), b = task & 3;
    const int t0 = pg * 4, tokbase = b * SEQ;
    {
      const int r = l31;
      const int qq = 2 * (r >> 4) + ((r >> 2) & 1), hh = (r & 3) + 4 * ((r >> 3) & 1);
      const half_t* ap = p.iq + (size_t)(tokbase + t0 + qq) * 512 + hh * 64 + half * 8;
      half8 a[4];
#pragma unroll
      for (int ks = 0; ks < 4; ++ks) a[ks] = *(const half8*)(ap + ks * 16);
      float wv[16];
#pragma unroll
      for (int g = 0; g < 16; ++g) {
        const int query = 2 * (g >> 3) + half, head = (g & 3) + 4 * ((g >> 2) & 1);
        wv[g] = p.iw[(size_t)(tokbase + t0 + query) * 8 + head] * idx_scale;
      }
      const int nkt = ((t0 + 3) >> 5) + 1;
      for (int kt = wave; kt < nkt; kt += 4) {
        const int s0 = kt * 32;
        const half_t* bp = p.ik + (size_t)(tokbase + s0 + l31) * 64 + half * 8;
        f32x16 acc;
#pragma unroll
        for (int g = 0; g < 16; ++g) acc[g] = 0.f;
#pragma unroll
        for (int ks = 0; ks < 4; ++ks) {
          half8 bb = *(const half8*)(bp + ks * 16);
          acc = __builtin_amdgcn_mfma_f32_32x32x16_f16(a[ks], bb, acc, 0, 0, 0);
        }
        float s_lo = 0.f, s_hi = 0.f;
#pragma unroll
        for (int g = 0; g < 8; ++g) s_lo += wv[g] * fmaxf(acc[g], 0.f);
#pragma unroll
        for (int g = 8; g < 16; ++g) s_hi += wv[g] * fmaxf(acc[g], 0.f);
        const int key = s0 + l31;
        sc[half * 8192 + key] = (key <= t0 + half) ? s_lo : NEG_INF;
        sc[(2 + half) * 8192 + key] = (key <= t0 + 2 + half) ? s_hi : NEG_INF;
      }
    }
    __syncthreads();
    {
      const int t = t0 + wave, n = t + 1;
      const float* row = sc + wave * 8192;
      uint32_t Tt = 0;
      int need_ties = 0;
      if (n > 256) {
        for (int bit = 31; bit >= 0; --bit) {
          const uint32_t cand = Tt | (1u << bit);
          int cnt = 0;
          for (int i = lane; i < n; i += 64) cnt += (fkey(row[i]) >= cand) ? 1 : 0;
          cnt = wave_sum_i(cnt);
          if (cnt >= 256) Tt = cand;
        }
        int cg = 0;
        for (int i = lane; i < n; i += 64) cg += (fkey(row[i]) > Tt) ? 1 : 0;
        cg = wave_sum_i(cg);
        need_ties = 256 - cg;
      }
      int tie_seen = 0;
      unsigned long long* mrow = (unsigned long long*)(p.mask + (size_t)(tokbase + t) * 256);
      for (int c = 0; c < 128; ++c) {
        const int key = c * 64 + lane;
        bool sel = false, tie = false;
        if (key < n) {
          if (n <= 256) sel = true;
          else {
            const uint32_t u = fkey(row[key]);
            if (u > Tt) sel = true;
            else if (u == Tt) tie = true;
          }
        }
        const unsigned long long tb = __ballot(tie);
        if (tie) {
          const int rank = tie_seen + __popcll(tb & ((1ull << lane) - 1ull));
          sel = rank < need_ties;
        }
        tie_seen += __popcll(tb);
        const unsigned long long sb = __ballot(sel);
        if (lane == 0) mrow[c] = sb;
      }
    }
    __syncthreads();
  }
}

__device__ __forceinline__ void phase_vt(const Params& p, half_t* sm, int bid, int nblk) {
  const int tid = threadIdx.x;
  for (int tile = bid; tile < 512 * 8; tile += nblk) {
    const int tt = tile >> 3, h = tile & 7;
    const int tok0 = tt * 64;
    const int b = tok0 >> 13, pos0 = tok0 & 8191;
#pragma unroll 4
    for (int i = 0; i < 16; ++i) {
      const int r = i * 4 + (tid >> 6), d = tid & 63;
      sm[r * 66 + d] = p.v[(size_t)(tok0 + r) * 512 + h * 64 + d];
    }
    __syncthreads();
#pragma unroll 4
    for (int i = 0; i < 16; ++i) {
      const int d = i * 4 + (tid >> 6), r = tid & 63;
      p.vt[((size_t)((b * 8 + h) * 64 + d)) * 8192 + pos0 + r] = sm[r * 66 + d];
    }
    __syncthreads();
  }
}

__device__ __forceinline__ void phase_attn(const Params& p, int bid, int nblk) {
  const int tid = threadIdx.x, lane = tid & 63, wave = tid >> 6;
  const int l15 = lane & 15, quad = lane >> 4;
  const float scl = 0.125f * 1.4426950408889634f;
  for (int bt = bid; bt < 4096; bt += nblk) {
    const int qg = 127 - (bt >> 5), rest = bt & 31, b = rest >> 3, head = rest & 7;
    const int q0 = qg * 64 + wave * 16, tokbase = b * SEQ;
    const int myq = q0 + l15;
    const half_t* qp = p.q + (size_t)(tokbase + myq) * 512 + head * 64 + quad * 8;
    const half8 bq0 = *(const half8*)qp, bq1 = *(const half8*)(qp + 32);
    f32x4 ot[4];
#pragma unroll
    for (int dt = 0; dt < 4; ++dt) ot[dt] = (f32x4){0.f, 0.f, 0.f, 0.f};
    float m = NEG_INF, l = 0.f;
    const int nsteps = ((q0 + 15) >> 6) + 1;
    const half_t* kbase = p.k + (size_t)tokbase * 512 + head * 64;
    const half_t* vtbase = p.vt + (size_t)((b * 8 + head) * 64) * 8192;
    const uint32_t* mrow = p.mask + (size_t)(tokbase + myq) * 256;
    for (int st = 0; st < nsteps; ++st) {
      const int s0 = st * 64;
      f32x4 s[4];
#pragma unroll
      for (int kt = 0; kt < 4; ++kt) {
        const half_t* kp = kbase + (size_t)(s0 + kt * 16 + l15) * 512 + quad * 8;
        const half8 a0 = *(const half8*)kp, a1 = *(const half8*)(kp + 32);
        f32x4 z = (f32x4){0.f, 0.f, 0.f, 0.f};
        z = __builtin_amdgcn_mfma_f32_16x16x32_f16(a0, bq0, z, 0, 0, 0);
        s[kt] = __builtin_amdgcn_mfma_f32_16x16x32_f16(a1, bq1, z, 0, 0, 0);
      }
      const uint2 mw = *(const uint2*)(mrow + st * 2);
      float xv[4][4];
      float mx = NEG_INF;
#pragma unroll
      for (int kt = 0; kt < 4; ++kt)
#pragma unroll
        for (int r = 0; r < 4; ++r) {
          const int ko = kt * 16 + quad * 4 + r;
          const uint32_t word = (kt < 2) ? mw.x : mw.y;
          const bool bit = (word >> (ko & 31)) & 1u;
          const float xx = bit ? s[kt][r] * scl : NEG_INF;
          xv[kt][r] = xx;
          mx = fmaxf(mx, xx);
        }
      mx = fmaxf(mx, __shfl_xor(mx, 16));
      mx = fmaxf(mx, __shfl_xor(mx, 32));
      const float m_new = fmaxf(m, mx);
      const float m_use = (m_new == NEG_INF) ? 0.f : m_new;
      const float alpha = exp2f(m - m_use);
      float psum = 0.f;
      float pv[4][4];
#pragma unroll
      for (int kt = 0; kt < 4; ++kt)
#pragma unroll
        for (int r = 0; r < 4; ++r) {
          const float e = exp2f(xv[kt][r] - m_use);
          pv[kt][r] = e;
          psum += e;
        }
      l = l * alpha + psum;
      m = m_new;
#pragma unroll
      for (int dt = 0; dt < 4; ++dt) ot[dt] = ot[dt] * alpha;
      half8 pb0, pb1;
#pragma unroll
      for (int r = 0; r < 4; ++r) {
        pb0[r] = (half_t)pv[0][r];
        pb0[4 + r] = (half_t)pv[1][r];
        pb1[r] = (half_t)pv[2][r];
        pb1[4 + r] = (half_t)pv[3][r];
      }
#pragma unroll
      for (int dt = 0; dt < 4; ++dt) {
        const half_t* vp = vtbase + (size_t)(dt * 16 + l15) * 8192 + s0 + quad * 4;
        const half4 v00 = *(const half4*)vp, v01 = *(const half4*)(vp + 16);
        const half4 v10 = *(const half4*)(vp + 32), v11 = *(const half4*)(vp + 48);
        half8 av0, av1;
#pragma unroll
        for (int r = 0; r < 4; ++r) {
          av0[r] = v00[r];
          av0[4 + r] = v01[r];
          av1[r] = v10[r];
          av1[4 + r] = v11[r];
        }
        ot[dt] = __builtin_amdgcn_mfma_f32_16x16x32_f16(av0, pb0, ot[dt], 0, 0, 0);
        ot[dt] = __builtin_amdgcn_mfma_f32_16x16x32_f16(av1, pb1, ot[dt], 0, 0, 0);
      }
    }
    l += __shfl_xor(l, 16);
    l += __shfl_xor(l, 32);
    const float inv = 1.f / l;
    half_t* op = p.yattn + (size_t)(tokbase + myq) * 512 + head * 64 + quad * 4;
#pragma unroll
    for (int dt = 0; dt < 4; ++dt) {
      half4 o;
#pragma unroll
      for (int r = 0; r < 4; ++r) o[r] = (half_t)(ot[dt][r] * inv);
      *(half4*)(op + dt * 16) = o;
    }
  }
}

__device__ __forceinline__ void phase_ymix(const Params& p, int bid, int nblk) {
  const int lane = threadIdx.x & 63, wave = threadIdx.x >> 6;
  for (int tok = bid * 4 + wave; tok < T_TOK; tok += nblk * 4) {
    const int pos = tok & 8191;
    const int c0 = lane * 8;
    {
      const half8 ya = *(const half8*)(p.yattn + (size_t)tok * 512 + c0);
      float f[8], ss = 0.f;
#pragma unroll
      for (int i = 0; i < 8; ++i) {
        f[i] = (float)ya[i];
        ss += f[i] * f[i];
      }
      ss = wave_sum(ss);
      const float rs = rsqrtf(ss * (1.f / 512.f) + 1e-6f);
      half8 o;
#pragma unroll
      for (int i = 0; i < 8; ++i) o[i] = (half_t)(f[i] * rs * p.attn_out_norm_w[c0 + i]);
      *(half8*)(p.ymix + (size_t)tok * 1024 + c0) = o;
    }
    {
      const half8 u0 = *(const half8*)(p.uu + (size_t)tok * 512 + c0);
      half8 u1, u2;
#pragma unroll
      for (int i = 0; i < 8; ++i) {
        u1[i] = (half_t)0.f;
        u2[i] = (half_t)0.f;
      }
      if (pos >= 1) u1 = *(const half8*)(p.uu + (size_t)(tok - 1) * 512 + c0);
      if (pos >= 2) u2 = *(const half8*)(p.uu + (size_t)(tok - 2) * 512 + c0);
      const half8 cbv = *(const half8*)(p.cb + (size_t)tok * 512 + c0);
      float y[8], ss = 0.f;
#pragma unroll
      for (int i = 0; i < 8; ++i) {
        const int c = c0 + i;
        float acc = p.conv_b[c] + p.conv_w[c] * (float)u2[i] + p.conv_w[512 + c] * (float)u1[i] +
                    p.conv_w[1024 + c] * (float)u0[i];
        y[i] = (float)cbv[i] * acc;
        ss += y[i] * y[i];
      }
      ss = wave_sum(ss);
      const float rs = rsqrtf(ss * (1.f / 512.f) + 1e-6f);
      half8 o;
#pragma unroll
      for (int i = 0; i < 8; ++i) o[i] = (half_t)(y[i] * rs * p.conv_out_norm_w[c0 + i]);
      *(half8*)(p.ymix + (size_t)tok * 1024 + 512 + c0) = o;
    }
  }
}

__device__ __forceinline__ float gelu_tanh(float x) {
  const float z = 0.7978845608028654f * (x + 0.044715f * x * x * x);
  const float e = __expf(2.f * z);
  const float th = 1.f - 2.f / (e + 1.f);
  return 0.5f * x * (1.f + th);
}

__device__ __forceinline__ void phase_peer(const Params& p, int bid, int nblk) {
  const int lane = threadIdx.x & 63, wave = threadIdx.x >> 6;
  for (int tok = bid * 4 + wave; tok < T_TOK; tok += nblk * 4) {
    const int b = tok >> 13;
    float hv[16], oacc[16];
#pragma unroll
    for (int c = 0; c < 4; ++c) {
      const half4 hh = *(const half4*)(p.h2 + (size_t)tok * 1024 + c * 256 + lane * 4);
#pragma unroll
      for (int i = 0; i < 4; ++i) {
        hv[c * 4 + i] = (float)hh[i];
        oacc[c * 4 + i] = 0.f;
      }
    }
    for (int head = 0; head < 8; ++head) {
      float tv[2];
      int ti[2];
#pragma unroll
      for (int pp = 0; pp < 2; ++pp) {
        const half_t* sp = p.ps + (size_t)tok * 2048 + (head * 2 + pp) * 128 + lane * 2;
        float v0 = (float)sp[0], v1 = (float)sp[1];
        float myv = NEG_INF;
        int myi = 0;
        for (int r = 0; r < 16; ++r) {
          const float mloc = fmaxf(v0, v1);
          const float M = wave_max(mloc);
          const unsigned long long bal = __ballot(mloc == M);
          const int src = __ffsll((long long)bal) - 1;
          const int iloc = (v0 == M) ? (lane * 2) : (lane * 2 + 1);
          const int idx = __shfl(iloc, src);
          if (lane == src) {
            if (v0 == M) v0 = NEG_INF;
            else v1 = NEG_INF;
          }
          if (lane == r) {
            myv = M;
            myi = idx;
          }
        }
        tv[pp] = myv;
        ti[pp] = myi;
      }
      float cv[4];
      int ci[4];
      {
        const float vi = __shfl(tv[0], lane >> 2);
        const int ii = __shfl(ti[0], lane >> 2);
#pragma unroll
        for (int jj = 0; jj < 4; ++jj) {
          const int j = 4 * (lane & 3) + jj;
          cv[jj] = vi + __shfl(tv[1], j);
          ci[jj] = ii * 128 + __shfl(ti[1], j);
        }
      }
      float topv = NEG_INF;
      int tope = 0;
      for (int r = 0; r < 16; ++r) {
        const float mloc = fmaxf(fmaxf(cv[0], cv[1]), fmaxf(cv[2], cv[3]));
        const float M = wave_max(mloc);
        const unsigned long long bal = __ballot(mloc == M);
        const int src = __ffsll((long long)bal) - 1;
        int eloc;
        if (cv[0] == M) eloc = ci[0];
        else if (cv[1] == M) eloc = ci[1];
        else if (cv[2] == M) eloc = ci[2];
        else eloc = ci[3];
        const int e = __shfl(eloc, src);
        if (lane == src) {
          if (cv[0] == M) cv[0] = NEG_INF;
          else if (cv[1] == M) cv[1] = NEG_INF;
          else if (cv[2] == M) cv[2] = NEG_INF;
          else cv[3] = NEG_INF;
        }
        if (lane == r) {
          topv = M;
          tope = e;
        }
      }
      const float mx = __shfl(topv, 0);
      float ex = (lane < 16) ? __expf(topv - mx) : 0.f;
      const float den = wave_sum(ex);
      const float gsm = ex / den;
      for (int r = 0; r < 16; ++r) {
        const int e = __shfl(tope, r);
        const float gr = __shfl(gsm, r);
        const half_t* ur = p.pu + (size_t)e * 1024 + lane * 4;
        float dot = 0.f;
#pragma unroll
        for (int c = 0; c < 4; ++c) {
          const half4 uv = *(const half4*)(ur + c * 256);
#pragma unroll
          for (int i = 0; i < 4; ++i) dot += (float)uv[i] * hv[c * 4 + i];
        }
        dot = wave_sum(dot);
        const float coef = gr * gelu_tanh(dot);
        const half_t* vr = p.pv + (size_t)e * 1024 + lane * 4;
#pragma unroll
        for (int c = 0; c < 4; ++c) {
          const half4 vv = *(const half4*)(vr + c * 256);
#pragma unroll
          for (int i = 0; i < 4; ++i) oacc[c * 4 + i] += coef * (float)vv[i];
        }
      }
    }
#pragma unroll
    for (int c = 0; c < 4; ++c) {
      const int e = c * 256 + lane * 4;
      float4 x1 = *(const float4*)(p.out + (size_t)tok * 1024 + e);
      const float4 g = *(const float4*)(p.mod + b * 6144 + 5120 + e);
      x1.x += g.x * oacc[c * 4 + 0];
      x1.y += g.y * oacc[c * 4 + 1];
      x1.z += g.z * oacc[c * 4 + 2];
      x1.w += g.w * oacc[c * 4 + 3];
      *(float4*)(p.out + (size_t)tok * 1024 + e) = x1;
    }
  }
}

__global__ __launch_bounds__(256) void k_prep(Params p) {
  __shared__ float sm[2 * 64 * 129];
  const int bid = blockIdx.x, nblk = gridDim.x;
  prep_ada(p, sm, bid, nblk);
  __syncthreads();
  prep_transpose<true>(p.w_in, p.wt_in, DIN, DINP, sm, bid, nblk);
  prep_transpose<false>(p.w_out, p.wt_out, 1024, 1024, sm, bid, nblk);
  prep_wprime(p, sm, bid, nblk);
  prep_tables(p, bid, nblk);
}
__global__ __launch_bounds__(256) void k_norm1(Params p) {
  phase_norm_mod(p.x, p.norm1_w, p.mod, 0, 1024, p.h, blockIdx.x, gridDim.x);
}
__global__ __launch_bounds__(256) void k_gemm_in(Params p) {
  __shared__ half_t sm[2 * 128 * 72];
  EpiIn e{p};
  phase_gemm(p.h, p.wt_in, 29, sm, e, blockIdx.x, gridDim.x);
}
__global__ __launch_bounds__(256) void k_index(Params p) {
  __shared__ float sc[4 * 8192];
  phase_index(p, sc, blockIdx.x, gridDim.x);
}
__global__ __launch_bounds__(256) void k_vt(Params p) {
  __shared__ half_t sm[64 * 66];
  phase_vt(p, sm, blockIdx.x, gridDim.x);
}
__global__ __launch_bounds__(256) void k_attn(Params p) { phase_attn(p, blockIdx.x, gridDim.x); }
__global__ __launch_bounds__(256) void k_ymix(Params p) { phase_ymix(p, blockIdx.x, gridDim.x); }
__global__ __launch_bounds__(256) void k_gemm_out(Params p) {
  __shared__ half_t sm[2 * 128 * 72];
  EpiOut e{p};
  phase_gemm(p.ymix, p.wt_out, 8, sm, e, blockIdx.x, gridDim.x);
}
__global__ __launch_bounds__(256) void k_norm2(Params p) {
  phase_norm_mod(p.out, p.norm2_w, p.mod, 3072, 4096, p.h2, blockIdx.x, gridDim.x);
}
__global__ __launch_bounds__(256) void k_gemm_ps(Params p) {
  __shared__ half_t sm[2 * 128 * 72];
  EpiPs e{p};
  phase_gemm(p.h2, p.wt_p, 16, sm, e, blockIdx.x, gridDim.x);
}
__global__ __launch_bounds__(256) void k_peer(Params p) { phase_peer(p, blockIdx.x, gridDim.x); }

extern "C" void kernel_launch(void* const* d_in, const int* in_sizes, int n_in, void* d_out, int out_size, void* d_ws,
                              size_t ws_size, hipStream_t stream) {
  Params p{};
  p.x = (const float*)d_in[0];
  p.c = (const float*)d_in[1];
  p.norm1_w = (const float*)d_in[2];
  p.norm2_w = (const float*)d_in[3];
  p.w_ada = (const float*)d_in[4];
  p.b_ada = (const float*)d_in[5];
  p.w_in = (const float*)d_in[6];
  p.q_norm_w = (const float*)d_in[7];
  p.k_norm_w = (const float*)d_in[8];
  p.conv_w = (const float*)d_in[9];
  p.conv_b = (const float*)d_in[10];
  p.attn_out_norm_w = (const float*)d_in[11];
  p.conv_out_norm_w = (const float*)d_in[12];
  p.w_out = (const float*)d_in[13];
  p.peer_wq = (const float*)d_in[14];
  p.peer_subkeys = (const float*)d_in[15];
  p.peer_u = (const float*)d_in[16];
  p.peer_v = (const float*)d_in[17];
  p.out = (float*)d_out;
  char* w = (char*)d_ws;
  size_t off = 0;
  auto take = [&](size_t bytes) {
    char* r = w + off;
    off += (bytes + 255) & ~(size_t)255;
    return r;
  };
  const size_t MB32 = (size_t)T_TOK * 512 * 2;
  p.mod = (float*)take(4 * 6144 * 4);
  p.wt_in = (half_t*)take((size_t)DINP * 1024 * 2);
  p.wt_out = (half_t*)take((size_t)1024 * 1024 * 2);
  p.wt_p = (half_t*)take((size_t)2048 * 1024 * 2);
  p.pu = (half_t*)take(MB32);
  p.pv = (half_t*)take(MB32);
  p.h = (half_t*)take(2 * MB32);
  p.ymix = p.h;
  p.q = (half_t*)take(MB32);
  p.k = (half_t*)take(MB32);
  p.v = (half_t*)take(MB32);
  p.vt = (half_t*)take(MB32);
  p.ps = p.q;
  p.cb = (half_t*)take(MB32);
  p.uu = (half_t*)take(MB32);
  p.h2 = p.cb;
  p.iq = (half_t*)take(MB32);
  p.ik = (half_t*)take((size_t)T_TOK * 64 * 2);
  p.iw = (float*)take((size_t)T_TOK * 8 * 4);
  p.mask = (uint32_t*)take((size_t)T_TOK * 256 * 4);
  p.yattn = (half_t*)take(MB32);
  (void)ws_size;
  (void)in_sizes;
  (void)n_in;
  (void)out_size;

  k_prep<<<1024, 256, 0, stream>>>(p);
  k_norm1<<<2048, 256, 0, stream>>>(p);
  k_gemm_in<<<7424, 256, 0, stream>>>(p);
  k_index<<<2048, 256, 0, stream>>>(p);
  k_vt<<<4096, 256, 0, stream>>>(p);
  k_attn<<<4096, 256, 0, stream>>>(p);
  k_ymix<<<2048, 256, 0, stream>>>(p);
  k_gemm_out<<<2048, 256, 0, stream>>>(p);
  k_norm2<<<2048, 256, 0, stream>>>(p);
  k_gemm_ps<<<4096, 256, 0, stream>>>(p);
  k_peer<<<2048, 256, 0, stream>>>(p);
}
```

```cpp
#include <hip/hip_runtime.h>
#include <hip/hip_fp16.h>
#include <hip/hip_cooperative_groups.h>
#include <stdint.h>

typedef _Float16 half_t;
typedef _Float16 half8 __attribute__((ext_vector_type(8)));
typedef _Float16 half4 __attribute__((ext_vector_type(4)));
typedef _Float16 half2v __attribute__((ext_vector_type(2)));
typedef float f32x2 __attribute__((ext_vector_type(2)));
typedef float f32x4 __attribute__((ext_vector_type(4)));
typedef float f32x16 __attribute__((ext_vector_type(16)));
typedef unsigned int u32x4 __attribute__((ext_vector_type(4)));

#define T_TOK 32768
#define SEQ 8192
#define NBATCH 4
#define DM 1024
#define DIN 3656
#define DINP 3840
#define NEG_INF (-__builtin_huge_valf())
#define NTHR 512
#define LAS __attribute__((address_space(3)))
#define NWAVE 8

struct Params {
  const float *x, *c, *norm1_w, *norm2_w, *w_ada, *b_ada, *w_in, *q_norm_w, *k_norm_w, *conv_w, *conv_b,
      *attn_out_norm_w, *conv_out_norm_w, *w_out, *peer_wq, *peer_subkeys, *peer_u, *peer_v;
  float* out;
  char* ws;
  __host__ __device__ __forceinline__ unsigned* bar() const { return (unsigned*)(ws + 0ull); }
  __host__ __device__ __forceinline__ float* mod() const { return (float*)(ws + 13824ull); }
  __host__ __device__ __forceinline__ half_t* wt_in() const { return (half_t*)(ws + 112128ull); }
  __host__ __device__ __forceinline__ half_t* wt_out() const { return (half_t*)(ws + 7976448ull); }
  __host__ __device__ __forceinline__ half_t* wt_p() const { return (half_t*)(ws + 10073600ull); }
  __host__ __device__ __forceinline__ int8_t* pu8() const { return (int8_t*)(ws + 14267904ull); }
  __host__ __device__ __forceinline__ uint8_t* pv8() const { return (uint8_t*)(ws + 31045120ull); }
  __host__ __device__ __forceinline__ float* uscale() const { return (float*)(ws + 47822336ull); }
  __host__ __device__ __forceinline__ float* hscale() const { return (float*)(ws + 47887872ull); }
  __host__ __device__ __forceinline__ half_t* h() const { return (half_t*)(ws + 48018944ull); }
  __host__ __device__ __forceinline__ half_t* ymix() const { return (half_t*)(ws + 48018944ull); }
  __host__ __device__ __forceinline__ uint16_t* eid() const { return (uint16_t*)(ws + 48018944ull); }
  __host__ __device__ __forceinline__ float* gw() const { return (float*)(ws + 56407552ull); }
  __host__ __device__ __forceinline__ float* coef() const { return (float*)(ws + 73184768ull); }
  __host__ __device__ __forceinline__ half_t* q() const { return (half_t*)(ws + 115127808ull); }
  __host__ __device__ __forceinline__ half_t* k() const { return (half_t*)(ws + 148682240ull); }
  __host__ __device__ __forceinline__ half_t* v() const { return (half_t*)(ws + 182236672ull); }
  __host__ __device__ __forceinline__ half_t* vt() const { return (half_t*)(ws + 215791104ull); }
  __host__ __device__ __forceinline__ half_t* ps() const { return (half_t*)(ws + 115127808ull); }
  __host__ __device__ __forceinline__ half_t* cb() const { return (half_t*)(ws + 249345536ull); }
  __host__ __device__ __forceinline__ half_t* uu() const { return (half_t*)(ws + 282899968ull); }
  __host__ __device__ __forceinline__ half_t* h2() const { return (half_t*)(ws + 249345536ull); }
  __host__ __device__ __forceinline__ half_t* iq() const { return (half_t*)(ws + 316454400ull); }
  __host__ __device__ __forceinline__ half_t* ik() const { return (half_t*)(ws + 350008832ull); }
  __host__ __device__ __forceinline__ float* iw() const { return (float*)(ws + 354203136ull); }
  __host__ __device__ __forceinline__ uint8_t* maskb() const { return (uint8_t*)(ws + 355251712ull); }
  __host__ __device__ __forceinline__ half_t* yattn() const { return (half_t*)(ws + 493663744ull); }
  __host__ __device__ __forceinline__ int8_t* h2q() const { return (int8_t*)(ws + 493663744ull); }
};

__device__ __forceinline__ int opq_tid() {
  int t = threadIdx.x;
  asm volatile("" : "+v"(t));
  return t;
}
#define TIDX opq_tid()

__device__ __forceinline__ int wave_sum_dpp(int v) {
  v += __builtin_amdgcn_update_dpp(0, v, 0x111, 0xF, 0xF, true);
  v += __builtin_amdgcn_update_dpp(0, v, 0x112, 0xF, 0xF, true);
  v += __builtin_amdgcn_update_dpp(0, v, 0x114, 0xF, 0xF, true);
  v += __builtin_amdgcn_update_dpp(0, v, 0x118, 0xF, 0xF, true);
  v += __builtin_amdgcn_update_dpp(0, v, 0x142, 0xA, 0xF, true);
  v += __builtin_amdgcn_update_dpp(0, v, 0x143, 0xC, 0xF, true);
  return __builtin_amdgcn_readlane(v, 63);
}
__device__ __forceinline__ int wave_max_dpp(int v) {
  v = max(v, __builtin_amdgcn_update_dpp(0, v, 0x111, 0xF, 0xF, true));
  v = max(v, __builtin_amdgcn_update_dpp(0, v, 0x112, 0xF, 0xF, true));
  v = max(v, __builtin_amdgcn_update_dpp(0, v, 0x114, 0xF, 0xF, true));
  v = max(v, __builtin_amdgcn_update_dpp(0, v, 0x118, 0xF, 0xF, true));
  v = max(v, __builtin_amdgcn_update_dpp(0, v, 0x142, 0xA, 0xF, true));
  v = max(v, __builtin_amdgcn_update_dpp(0, v, 0x143, 0xC, 0xF, true));
  return __builtin_amdgcn_readlane(v, 63);
}
__device__ __forceinline__ float wave_sum(float v) {
#pragma unroll
  for (int o = 32; o >= 1; o >>= 1) v += __shfl_xor(v, o);
  return v;
}
__device__ __forceinline__ int wave_sum_i(int v) {
#pragma unroll
  for (int o = 32; o >= 1; o >>= 1) v += __shfl_xor(v, o);
  return v;
}
__device__ __forceinline__ float wave_max(float v) {
#pragma unroll
  for (int o = 32; o >= 1; o >>= 1) v = fmaxf(v, __shfl_xor(v, o));
  return v;
}

__device__ __forceinline__ void prep_ada(const Params& p, float* sm, int bid, int nblk) {
  float* s_silu = sm;
  float* red = sm + 4096;
  const int tid = TIDX;
  for (int i = tid; i < 4096; i += NTHR) {
    float cv = p.c[i];
    s_silu[i] = cv / (1.f + __expf(-cv));
  }
  __syncthreads();
  for (int tile = bid; tile < 192; tile += nblk) {
    const int col = tid & 31, ks = tid >> 5;
    const int j = tile * 32 + col;
    float a0 = 0, a1 = 0, a2 = 0, a3 = 0;
    const float* wp = p.w_ada + (size_t)(ks * 64) * 6144 + j;
#pragma unroll 8
    for (int kk = 0; kk < 64; ++kk) {
      const float w = wp[(size_t)kk * 6144];
      const int k = ks * 64 + kk;
      a0 += s_silu[k] * w;
      a1 += s_silu[1024 + k] * w;
      a2 += s_silu[2048 + k] * w;
      a3 += s_silu[3072 + k] * w;
    }
    red[(ks * 4 + 0) * 32 + col] = a0;
    red[(ks * 4 + 1) * 32 + col] = a1;
    red[(ks * 4 + 2) * 32 + col] = a2;
    red[(ks * 4 + 3) * 32 + col] = a3;
    __syncthreads();
    if (tid < 128) {
      const int b = tid >> 5, jj = tid & 31;
      float sum = 0.f;
#pragma unroll
      for (int q = 0; q < 16; ++q) sum += red[(q * 4 + b) * 32 + jj];
      p.mod()[b * 6144 + tile * 32 + jj] = sum + p.b_ada[tile * 32 + jj];
    }
    __syncthreads();
  }
}

__device__ __forceinline__ int perm_in_col(int n) {
  if (n >= DIN) return -1;
  if (n >= 2048 && n < 3072) {
    int g = (n - 2048) >> 6, jj = (n - 2048) & 63;
    return (jj < 32) ? (2048 + g * 32 + jj) : (2560 + g * 32 + (jj - 32));
  }
  return n;
}

template <bool PERM>
__device__ __forceinline__ void prep_transpose(const float* __restrict__ src, half_t* __restrict__ dst, int N, int Npad, float* sm,
                               int bid, int nblk) {
  const int tid = TIDX;
  const int ntn = Npad / 64;
  for (int tile = bid; tile < ntn * 16; tile += nblk) {
    const int nt = tile / 16, kt = tile % 16;
    const int n0 = nt * 64, k0 = kt * 64;
#pragma unroll 4
    for (int i = 0; i < 8; ++i) {
      int kk = i * 8 + (tid >> 6), nn = tid & 63;
      int n = n0 + nn;
      float v = 0.f;
      if (PERM || n < N) {
        int col = PERM ? perm_in_col(n) : n;
        if (col >= 0) v = src[(size_t)(k0 + kk) * N + col];
      }
      sm[kk * 65 + nn] = v;
    }
    __syncthreads();
#pragma unroll 4
    for (int i = 0; i < 8; ++i) {
      int nn = i * 8 + (tid >> 6), kk = tid & 63;
      dst[(size_t)(n0 + nn) * 1024 + k0 + kk] = (half_t)sm[kk * 65 + nn];
    }
    __syncthreads();
  }
}

__device__ __forceinline__ void prep_wprime(const Params& p, float* sm, int bid, int nblk) {
  float* sA = sm;
  float* sB = sm + 64 * 129;
  const int tid = TIDX;
  for (int tile = bid; tile < 512; tile += nblk) {
    const int hp = tile >> 5, nt = (tile >> 4) & 1, kt = tile & 15;
    const int n0 = nt * 64, k0 = kt * 64;
    for (int i = tid; i < 64 * 128; i += NTHR) {
      int r = i >> 7, d = i & 127;
      sA[r * 129 + d] = p.peer_subkeys[((size_t)(hp * 128 + n0 + r)) * 128 + d];
      sB[r * 129 + d] = p.peer_wq[(size_t)(k0 + r) * 2048 + hp * 128 + d];
    }
    __syncthreads();
    const int tn = tid >> 4, tk = tid & 15;
    float acc[2][4];
#pragma unroll
    for (int a = 0; a < 2; ++a)
#pragma unroll
      for (int b = 0; b < 4; ++b) acc[a][b] = 0.f;
    for (int d = 0; d < 128; ++d) {
      float av[2], bv[4];
#pragma unroll
      for (int a = 0; a < 2; ++a) av[a] = sA[(tn * 2 + a) * 129 + d];
#pragma unroll
      for (int b = 0; b < 4; ++b) bv[b] = sB[(tk * 4 + b) * 129 + d];
#pragma unroll
      for (int a = 0; a < 2; ++a)
#pragma unroll
        for (int b = 0; b < 4; ++b) acc[a][b] += av[a] * bv[b];
    }
#pragma unroll
    for (int a = 0; a < 2; ++a)
#pragma unroll
      for (int b = 0; b < 4; ++b)
        p.wt_p()[(size_t)(hp * 128 + n0 + tn * 2 + a) * 1024 + k0 + tk * 4 + b] = (half_t)acc[a][b];
    __syncthreads();
  }
}

__device__ __forceinline__ void prep_tables(const Params& p, int bid, int nblk) {
  const int lane = TIDX & 63, wave = TIDX >> 6;
  for (int e = bid * NWAVE + wave; e < 16384; e += nblk * NWAVE) {
    const float4* ur = (const float4*)(p.peer_u + (size_t)e * 1024 + lane * 16);
    const float4* vr = (const float4*)(p.peer_v + (size_t)e * 1024 + lane * 16);
    float4 u[4], v[4];
#pragma unroll
    for (int c = 0; c < 4; ++c) {
      u[c] = ur[c];
      v[c] = vr[c];
    }
    float am = 0.f;
#pragma unroll
    for (int c = 0; c < 4; ++c)
      am = fmaxf(am, fmaxf(fmaxf(fabsf(u[c].x), fabsf(u[c].y)), fmaxf(fabsf(u[c].z), fabsf(u[c].w))));
    am = wave_max(am);
    am = fmaxf(am, 1e-20f);
    const float inv = 127.f / am;
    u32x4 qu, qv;
#pragma unroll
    for (int c = 0; c < 4; ++c) {
      int q0 = (int)rintf(u[c].x * inv), q1 = (int)rintf(u[c].y * inv), q2 = (int)rintf(u[c].z * inv),
          q3 = (int)rintf(u[c].w * inv);
      qu[c] = (uint32_t)(q0 & 255) | ((uint32_t)(q1 & 255) << 8) | ((uint32_t)(q2 & 255) << 16) |
              ((uint32_t)(q3 & 255) << 24);
      float f0 = fminf(fmaxf(v[c].x * 128.f, -448.f), 448.f), f1 = fminf(fmaxf(v[c].y * 128.f, -448.f), 448.f);
      float f2 = fminf(fmaxf(v[c].z * 128.f, -448.f), 448.f), f3 = fminf(fmaxf(v[c].w * 128.f, -448.f), 448.f);
      int pk = __builtin_amdgcn_cvt_pk_fp8_f32(f0, f1, 0, false);
      pk = __builtin_amdgcn_cvt_pk_fp8_f32(f2, f3, pk, true);
      qv[c] = (uint32_t)pk;
    }
    const int r = (e & 7) * 2048 + (e >> 3);
    *(u32x4*)(p.pu8() + (size_t)r * 1024 + lane * 16) = qu;
    *(u32x4*)(p.pv8() + ((size_t)(lane >> 3) * 16384 + e) * 128 + (lane & 7) * 16) = qv;
    if (lane == 0) p.uscale()[e] = am * (1.f / 127.f);
  }
}

template <bool QUANT>
__device__ __forceinline__ void phase_norm_mod(const float* __restrict__ xin, const float* __restrict__ nw,
                                               const float* __restrict__ mod, int shift_off, int scale_off,
                                               half_t* __restrict__ hout, int8_t* __restrict__ qout,
                                               float* __restrict__ qscale, int bid, int nblk) {
  const int lane = TIDX & 63, wave = TIDX >> 6;
  for (int tok = bid * NWAVE + wave; tok < T_TOK; tok += nblk * NWAVE) {
    const int b = tok >> 13;
    const float4* xr = (const float4*)(xin + (size_t)tok * 1024);
    float4 v[4];
    float ss = 0.f;
#pragma unroll
    for (int c = 0; c < 4; ++c) {
      v[c] = xr[c * 64 + lane];
      ss += v[c].x * v[c].x + v[c].y * v[c].y + v[c].z * v[c].z + v[c].w * v[c].w;
    }
    ss = wave_sum(ss);
    const float rs = rsqrtf(ss * (1.f / 1024.f) + 1e-6f);
    float am = 0.f;
#pragma unroll
    for (int c = 0; c < 4; ++c) {
      const int e = c * 256 + lane * 4;
      float4 w = *(const float4*)(nw + e);
      float4 sc = *(const float4*)(mod + b * 6144 + scale_off + e);
      float4 sh = *(const float4*)(mod + b * 6144 + shift_off + e);
      v[c].x = v[c].x * rs * w.x * (1.f + sc.x) + sh.x;
      v[c].y = v[c].y * rs * w.y * (1.f + sc.y) + sh.y;
      v[c].z = v[c].z * rs * w.z * (1.f + sc.z) + sh.z;
      v[c].w = v[c].w * rs * w.w * (1.f + sc.w) + sh.w;
      half4 o;
      o[0] = (half_t)v[c].x;
      o[1] = (half_t)v[c].y;
      o[2] = (half_t)v[c].z;
      o[3] = (half_t)v[c].w;
      *(half4*)(hout + (size_t)tok * 1024 + e) = o;
      if (QUANT) am = fmaxf(am, fmaxf(fmaxf(fabsf(v[c].x), fabsf(v[c].y)), fmaxf(fabsf(v[c].z), fabsf(v[c].w))));
    }
    if (QUANT) {
      am = fmaxf(wave_max(am), 1e-20f);
      const float inv = 127.f / am;
#pragma unroll
      for (int c = 0; c < 4; ++c) {
        int q0 = (int)rintf(v[c].x * inv), q1 = (int)rintf(v[c].y * inv), q2 = (int)rintf(v[c].z * inv),
            q3 = (int)rintf(v[c].w * inv);
        uint32_t pk = (uint32_t)(q0 & 255) | ((uint32_t)(q1 & 255) << 8) | ((uint32_t)(q2 & 255) << 16) |
                      ((uint32_t)(q3 & 255) << 24);
        *(uint32_t*)(qout + (size_t)tok * 1024 + c * 256 + lane * 4) = pk;
      }
      if (lane == 0) qscale[tok] = am * (1.f / 127.f);
    }
  }
}

#define G8_BK 64
#define G8_HT (128 * 64)
__device__ __forceinline__ int g8_lds_byte(int r, int c) {
  int st = (r >> 4) * 2 + (c >> 5), rr = r & 15, cc = c & 31, ob = rr * 64 + cc * 2;
  return st * 1024 + (ob ^ (((ob >> 9) & 1) << 5));
}
__device__ __forceinline__ void g8_stage_rc(int b, int& R, int& C) {
  int st = b / 1024, sb = b % 1024, swz = sb ^ (((sb >> 9) & 1) << 5);
  R = (st >> 1) * 16 + swz / 64;
  C = (st & 1) * 32 + (swz % 64) / 2;
}
typedef f32x4 g8acc_t[2][2][4][2];

template <class Epi>
__device__ __forceinline__ void gemm8_tile(const half_t* __restrict__ A, const half_t* __restrict__ Bt, const int K,
                                           const int brow, const int bcol, half_t* shm, const Epi& epi) {
#define G8_SA(b, h) (shm + ((b) * 2 + (h)) * G8_HT)
#define G8_SB(b, h) (shm + (4 + (b) * 2 + (h)) * G8_HT)
#define G8_STAGE(P, BASE, br, kt)                                                                          \
  do {                                                                                                     \
    const char* _gb = (const char*)(BASE) + ((long)(br) * K + (long)(kt) * G8_BK) * 2;                     \
    __builtin_amdgcn_global_load_lds((const unsigned*)(_gb + voff0), (LAS unsigned*)((char*)(P) + TIDX * 16), 16, 0, 0);        \
    __builtin_amdgcn_global_load_lds((const unsigned*)(_gb + voff1), (LAS unsigned*)((char*)(P) + TIDX * 16 + 8192), 16, 0, 0); \
  } while (0)
#define G8_LDA(dst, b, h)                                                                                  \
  for (int m = 0; m < 4; ++m)                                                                              \
    for (int k = 0; k < 2; ++k)                                                                            \
  dst[m][k] = *reinterpret_cast<const half8*>(baseA + (((b) * 2 + (h)) * 16384 + m * 2048 + k * 1024))
#define G8_LDB(dst, b, h)                                                                                  \
  for (int n = 0; n < 2; ++n)                                                                              \
    for (int k = 0; k < 2; ++k)                                                                            \
  dst[n][k] = *reinterpret_cast<const half8*>(baseB + (((b) * 2 + (h)) * 16384 + n * 2048 + k * 1024))
#define G8_MMA(ai, bj, At, Bx)                                                                             \
  do {                                                                                                     \
    __builtin_amdgcn_s_setprio(1);                                                                         \
    for (int m = 0; m < 4; ++m)                                                                            \
      for (int n = 0; n < 2; ++n)                                                                          \
        for (int k = 0; k < 2; ++k)                                                                        \
          acc[ai][bj][m][n] =                                                                              \
              __builtin_amdgcn_mfma_f32_16x16x32_f16(At[m][k], Bx[n][k], acc[ai][bj][m][n], 0, 0, 0);      \
    __builtin_amdgcn_s_setprio(0);                                                                         \
  } while (0)
#define G8_WAIT_V(n) asm volatile("s_waitcnt vmcnt(" #n ")" ::: "memory")
#define G8_WAIT_L(n) asm volatile("s_waitcnt lgkmcnt(" #n ")" ::: "memory")
#define G8_BAR __builtin_amdgcn_s_barrier()
#define G8_SCHED __builtin_amdgcn_sched_barrier(0)
  const int wid = TIDX >> 6, lane = TIDX & 63, wr = wid >> 2, wc = wid & 3, fr = lane & 15, fq = lane >> 4;
  const char* baseA;
  const char* baseB;
  {
    unsigned lb = (unsigned)g8_lds_byte(fr, fq * 8);
    unsigned oa = lb + wr * 8192, ob = lb + wc * 4096 + 65536;
    asm volatile("" : "+v"(oa));
    asm volatile("" : "+v"(ob));
    baseA = (const char*)shm + oa;
    baseB = (const char*)shm + ob;
  }
  unsigned voff0, voff1;
  {
    int r0, c0, r1, c1;
    g8_stage_rc(TIDX * 16, r0, c0);
    g8_stage_rc(TIDX * 16 + 8192, r1, c1);
    voff0 = (unsigned)(r0 * K + c0) * 2u;
    voff1 = (unsigned)(r1 * K + c1) * 2u;
    asm volatile("" : "+v"(voff0));
    asm volatile("" : "+v"(voff1));
  }
  g8acc_t acc;
#pragma unroll
  for (int a = 0; a < 2; ++a)
#pragma unroll
    for (int b = 0; b < 2; ++b)
#pragma unroll
      for (int m = 0; m < 4; ++m)
#pragma unroll
        for (int n = 0; n < 2; ++n) acc[a][b][m][n] = (f32x4){0.f, 0.f, 0.f, 0.f};
  half8 At[4][2], B0[2][2], B1[2][2];
  const int nt = K / G8_BK;
  asm volatile("s_waitcnt vmcnt(0)" ::: "memory");
  G8_STAGE(G8_SB(0, 0), Bt, bcol, 0);
  G8_STAGE(G8_SA(0, 0), A, brow, 0);
  G8_STAGE(G8_SB(0, 1), Bt, bcol + 128, 0);
  G8_STAGE(G8_SA(0, 1), A, brow + 128, 0);
  if (wr == 1) G8_BAR;
  G8_WAIT_V(4);
  G8_BAR;
  G8_STAGE(G8_SB(1, 0), Bt, bcol, 1);
  G8_STAGE(G8_SA(1, 0), A, brow, 1);
  G8_STAGE(G8_SB(1, 1), Bt, bcol + 128, 1);
  G8_WAIT_V(6);
  G8_BAR;
#pragma unroll 1
  for (int t = 0; t < nt - 2; t += 2) {
    G8_LDB(B0, 0, 0); G8_SCHED; G8_LDA(At, 0, 0); G8_STAGE(G8_SA(1, 1), A, brow + 128, t + 1);
    G8_WAIT_L(8); G8_BAR; G8_WAIT_L(0); G8_MMA(0, 0, At, B0); G8_BAR; G8_SCHED;
    G8_LDB(B1, 0, 1); G8_STAGE(G8_SB(0, 0), Bt, bcol, t + 2);
    G8_BAR; G8_WAIT_L(0); G8_MMA(0, 1, At, B1); G8_BAR;
    G8_LDA(At, 0, 1); G8_STAGE(G8_SA(0, 0), A, brow, t + 2);
    G8_BAR; G8_WAIT_L(0); G8_MMA(1, 0, At, B0); G8_BAR; G8_SCHED;
    G8_STAGE(G8_SB(0, 1), Bt, bcol + 128, t + 2);
    G8_WAIT_V(6); G8_BAR; G8_MMA(1, 1, At, B1); G8_BAR;
    G8_LDB(B0, 1, 0); G8_SCHED; G8_LDA(At, 1, 0); G8_STAGE(G8_SA(0, 1), A, brow + 128, t + 2);
    G8_WAIT_L(8); G8_BAR; G8_WAIT_L(0); G8_MMA(0, 0, At, B0); G8_BAR; G8_SCHED;
    G8_LDB(B1, 1, 1); G8_STAGE(G8_SB(1, 0), Bt, bcol, t + 3);
    G8_BAR; G8_WAIT_L(0); G8_MMA(0, 1, At, B1); G8_BAR;
    G8_LDA(At, 1, 1); G8_STAGE(G8_SA(1, 0), A, brow, t + 3);
    G8_BAR; G8_WAIT_L(0); G8_MMA(1, 0, At, B0); G8_BAR; G8_SCHED;
    G8_STAGE(G8_SB(1, 1), Bt, bcol + 128, t + 3);
    G8_WAIT_V(6); G8_BAR; G8_MMA(1, 1, At, B1); G8_BAR;
  }
  {
    G8_LDB(B0, 0, 0); G8_LDA(At, 0, 0); G8_STAGE(G8_SA(1, 1), A, brow + 128, nt - 1);
    G8_BAR; G8_WAIT_L(0); G8_MMA(0, 0, At, B0); G8_BAR;
    G8_LDB(B1, 0, 1); G8_BAR; G8_WAIT_L(0); G8_MMA(0, 1, At, B1); G8_BAR;
    G8_LDA(At, 0, 1); G8_WAIT_V(4); G8_BAR; G8_WAIT_L(0); G8_MMA(1, 0, At, B0); G8_MMA(1, 1, At, B1); G8_BAR;
  }
  {
    G8_LDB(B0, 1, 0); G8_LDA(At, 1, 0); G8_WAIT_V(2); G8_BAR; G8_WAIT_L(0); G8_MMA(0, 0, At, B0); G8_BAR;
    G8_LDB(B1, 1, 1); G8_WAIT_V(0); G8_BAR; G8_WAIT_L(0); G8_MMA(0, 1, At, B1); G8_BAR;
    G8_LDA(At, 1, 1); G8_BAR; G8_WAIT_L(0); G8_MMA(1, 0, At, B0); G8_MMA(1, 1, At, B1); G8_BAR;
  }
  if (wr == 0) G8_BAR;
  {
    unsigned w0 = (unsigned)(wr * 65536 + fq * 4096 + ((((wc * 32) ^ ((fq >> 1) << 5)) + ((fq & 1) << 4) + fr) << 2));
    asm volatile("" : "+v"(w0));
    char* wb0 = (char*)shm + w0;
    char* wb1 = (char*)shm + (w0 ^ 64u);
#pragma unroll
    for (int ai = 0; ai < 2; ++ai) {
#pragma unroll
      for (int bj = 0; bj < 2; ++bj)
#pragma unroll
        for (int m = 0; m < 4; ++m)
#pragma unroll
          for (int j = 0; j < 4; ++j) {
            *(float*)(wb0 + (bj * 512 + (m * 16 + j) * 1024)) = acc[ai][bj][m][0][j];
            *(float*)(wb1 + (bj * 512 + (m * 16 + j) * 1024)) = acc[ai][bj][m][1][j];
          }
      __syncthreads();
      const float* ct = (const float*)shm;
      if (Epi::kVT && bcol >= 1024 && bcol < 1536) {
        const int wv_ = TIDX >> 6, r0 = 2 * lane;
        const float* rp = ct + r0 * 256;
        const int sw = ((r0 >> 2) & 3) << 4;
        half_t* vtp = epi.p.vt() + ((size_t)((brow >> 13) * 512 + (bcol - 1024) + wv_ * 32)) * 8192 + (brow & 8191) + ai * 128 + r0;
#pragma unroll 2
        for (int cg = 0; cg < 8; ++cg) {
          const int cc = (wv_ * 32 + cg * 4) ^ sw;
          const f32x4 v0 = *(const f32x4*)(rp + cc), v1 = *(const f32x4*)(rp + 256 + cc);
#pragma unroll
          for (int i = 0; i < 4; ++i) {
            half2v o;
            o[0] = (half_t)v0[i];
            o[1] = (half_t)v1[i];
            *(half2v*)(vtp + (size_t)(cg * 4 + i) * 8192) = o;
          }
        }
      } else {
#pragma unroll 1
        for (int it = 0; it < 16; ++it) {
          const int id = it * 512 + TIDX;
          const int row = id >> 6, c4 = id & 63;
          const f32x4 v = *(const f32x4*)(ct + row * 256 + ((c4 * 4) ^ (((row >> 2) & 3) << 4)));
          epi(v, brow + ai * 128 + row, bcol + c4 * 4, lane);
        }
      }
      __syncthreads();
    }
  }
}

struct EpiIn {
  Params p;
  static constexpr bool kVT = true;
  __host__ __device__ __forceinline__ void operator()(const f32x4& v, int row, int col, int lane) const {
    const int cb = col & ~63, cin = col & 63;
    if (cb < 1024) {
      float ss = v[0] * v[0] + v[1] * v[1] + v[2] * v[2] + v[3] * v[3];
      ss += __shfl_xor(ss, 1);
      ss += __shfl_xor(ss, 2);
      ss += __shfl_xor(ss, 4);
      ss += __shfl_xor(ss, 8);
      const bool isq = cb < 512;
      const float rs = rsqrtf(ss * (1.f / 64.f) + 1e-6f) * (isq ? (-0.125f * 1.4426950408889634f) : 1.f);
      const f32x4 w = *(const f32x4*)((isq ? p.q_norm_w : p.k_norm_w) + cin);
      half4 o;
#pragma unroll
      for (int i = 0; i < 4; ++i) o[i] = (half_t)(v[i] * rs * w[i]);
      *(half4*)((isq ? p.q() : p.k()) + (size_t)row * 512 + (col & 511)) = o;
    } else if (cb < 2048) {
      half4 o;
#pragma unroll
      for (int i = 0; i < 4; ++i) o[i] = (half_t)v[i];
      if (cb >= 1536) *(half4*)(p.cb() + (size_t)row * 512 + (col & 511)) = o;
    } else if (cb < 3072) {
      f32x4 o;
#pragma unroll
      for (int i = 0; i < 4; ++i) o[i] = __shfl_xor(v[i], 8);
      if (cin < 32) {
        half4 u;
#pragma unroll
        for (int i = 0; i < 4; ++i) u[i] = (half_t)(v[i] * o[i]);
        *(half4*)(p.uu() + (size_t)row * 512 + ((cb - 2048) >> 1) + cin) = u;
      }
    } else if (cb < 3584) {
      half4 o;
#pragma unroll
      for (int i = 0; i < 4; ++i) o[i] = (half_t)v[i];
      *(half4*)(p.iq() + (size_t)row * 512 + (col - 3072)) = o;
    } else if (cb == 3584) {
      half4 o;
#pragma unroll
      for (int i = 0; i < 4; ++i) o[i] = (half_t)v[i];
      *(half4*)(p.ik() + (size_t)(row >> 5) * 2048 + (cin >> 4) * 512 + ((cin >> 3) & 1) * 256 + (row & 31) * 8 + (cin & 7)) = o;
    } else if (cb == 3648 && cin < 8) {
      *(f32x4*)(p.iw() + (size_t)row * 8 + cin) = v;
    }
  }
};

struct EpiOut {
  Params p;
  static constexpr bool kVT = false;
  __host__ __device__ __forceinline__ void operator()(const f32x4& v, int row, int col, int lane) const {
    const int b = row >> 13;
    const f32x4 g = *(const f32x4*)(p.mod() + b * 6144 + 2048 + col);
    const f32x4 x = *(const f32x4*)(p.x + (size_t)row * 1024 + col);
    *(f32x4*)(p.out + (size_t)row * 1024 + col) = x + g * v;
  }
};

struct EpiPs {
  Params p;
  static constexpr bool kVT = false;
  __host__ __device__ __forceinline__ void operator()(const f32x4& v, int row, int col, int lane) const {
    half4 o;
#pragma unroll
    for (int i = 0; i < 4; ++i) o[i] = (half_t)v[i];
    *(half4*)(p.ps() + (size_t)row * 2048 + col) = o;
  }
};

template <class Epi>
__device__ __forceinline__ void phase_gemm(const half_t* A, const half_t* Bt, int nN, half_t* sm, const Epi& epi, int bid, int nblk) {
  const int nM = T_TOK / 256;
  const int nwg = nM * nN;
  for (int w0 = bid; w0 < nwg; w0 += nblk) {
    int wgid = w0;
    {
      const int q = nwg / 8, r = nwg % 8, xcd = wgid % 8, off = wgid / 8;
      wgid = (xcd < r ? xcd * (q + 1) : r * (q + 1) + (xcd - r) * q) + off;
    }
    const int nig = 8 * nN, gid = wgid / nig, fm = gid * 8;
    const int gsz = min(nM - fm, 8);
    const int pm = fm + ((wgid % nig) % gsz), pn = (wgid % nig) / gsz;
    gemm8_tile(A, Bt, 1024, pm * 256, pn * 256, sm, epi);
  }
}

__device__ __forceinline__ size_t mask_unit(int b, int qb) {
  return (size_t)b * (65536ull * 528ull) + 65536ull * (size_t)(qb * (qb + 1) / 2);
}
__device__ __forceinline__ size_t mask_addr(int b, int t, int tile, int g, int hi) {
  const int qb = t >> 8, ntiles = 4 * qb + 4;
  return mask_unit(b, qb) + (size_t)(((t & 255) >> 5) * ntiles + tile) * 2048 + (g >> 2) * 1024 + (hi * 32 + (t & 31)) * 16 + (g & 3) * 4;
}
__device__ __forceinline__ uint32_t fkey(float f) {
  uint32_t u = __float_as_uint(f);
  return (u & 0x80000000u) ? ~u : (u | 0x80000000u);
}

typedef unsigned short us2 __attribute__((ext_vector_type(2)));
__device__ __forceinline__ uint32_t pk_subsat(uint32_t a, uint32_t b) {
  return __builtin_bit_cast(uint32_t, __builtin_elementwise_sub_sat(__builtin_bit_cast(us2, a), __builtin_bit_cast(us2, b)));
}
__device__ __forceinline__ uint32_t pk_sub(uint32_t a, uint32_t b) {
  return __builtin_bit_cast(uint32_t, (us2)(__builtin_bit_cast(us2, a) - __builtin_bit_cast(us2, b)));
}
__device__ __forceinline__ uint32_t pk_min(uint32_t a, uint32_t b) {
  return __builtin_bit_cast(uint32_t, __builtin_elementwise_min(__builtin_bit_cast(us2, a), __builtin_bit_cast(us2, b)));
}
__device__ __forceinline__ uint32_t pk_max(uint32_t a, uint32_t b) {
  return __builtin_bit_cast(uint32_t, __builtin_elementwise_max(__builtin_bit_cast(us2, a), __builtin_bit_cast(us2, b)));
}
__device__ __forceinline__ uint32_t pk_add(uint32_t a, uint32_t b) {
  return __builtin_bit_cast(uint32_t, (us2)(__builtin_bit_cast(us2, a) + __builtin_bit_cast(us2, b)));
}
typedef short s16x2 __attribute__((ext_vector_type(2)));

#define CEX(a, b)                      \
  {                                    \
    const uint32_t _h = max(a, b);     \
    const uint32_t _l = min(a, b);     \
    a = _h;                            \
    b = _l;                            \
  }
#define IDX_COUNT(dst, thr_m1_x2)                                                                 \
  {                                                                                               \
    uint32_t _c0 = 0, _c1 = 0, _c2 = 0, _c3 = 0;                                                  \
    _Pragma("unroll") for (int g = 0; g < 16; g += 2) {                                           \
      if (g < NG) {                                                                               \
        _c0 = pk_add(_c0, pk_min(pk_subsat(kx[4 * g + 0], (thr_m1_x2)), one));                    \
        _c1 = pk_add(_c1, pk_min(pk_subsat(kx[4 * g + 1], (thr_m1_x2)), one));                    \
        _c2 = pk_add(_c2, pk_min(pk_subsat(kx[4 * g + 2], (thr_m1_x2)), one));                    \
        _c3 = pk_add(_c3, pk_min(pk_subsat(kx[4 * g + 3], (thr_m1_x2)), one));                    \
        _c0 = pk_add(_c0, pk_min(pk_subsat(kx[4 * g + 4], (thr_m1_x2)), one));                    \
        _c1 = pk_add(_c1, pk_min(pk_subsat(kx[4 * g + 5], (thr_m1_x2)), one));                    \
        _c2 = pk_add(_c2, pk_min(pk_subsat(kx[4 * g + 6], (thr_m1_x2)), one));                    \
        _c3 = pk_add(_c3, pk_min(pk_subsat(kx[4 * g + 7], (thr_m1_x2)), one));                    \
      }                                                                                           \
    }                                                                                             \
    const uint32_t _c = pk_add(pk_add(_c0, _c1), pk_add(_c2, _c3));                               \
    int _s = (int)((_c & 0xffffu) + (_c >> 16));                                                  \
    dst = wave_sum_dpp(_s);                                                                       \
  }

__device__ __forceinline__ float relu1(float x) { return __int_as_float(max(__float_as_int(x), 0)); }

#define IDX_COUNTC(dst, thr_m1_x2)                                                                \
  {                                                                                               \
    uint32_t _c0 = 0, _c1 = 0, _c2 = 0, _c3 = 0;                                                  \
    _Pragma("unroll") for (int g = 0; g < 16; ++g) {                                              \
      if (g < NGC) {                                                                              \
        _c0 = pk_add(_c0, pk_min(pk_subsat(kx[4 * g + 0], (thr_m1_x2)), one));                    \
        _c1 = pk_add(_c1, pk_min(pk_subsat(kx[4 * g + 1], (thr_m1_x2)), one));                    \
        _c2 = pk_add(_c2, pk_min(pk_subsat(kx[4 * g + 2], (thr_m1_x2)), one));                    \
        _c3 = pk_add(_c3, pk_min(pk_subsat(kx[4 * g + 3], (thr_m1_x2)), one));                    \
      }                                                                                           \
    }                                                                                             \
    const uint32_t _c = pk_add(pk_add(_c0, _c1), pk_add(_c2, _c3));                               \
    int _s = (int)((_c & 0xffffu) + (_c >> 16));                                                  \
    dst = wave_sum_dpp(_s);                                                                       \
  }
template <int NGC>
__device__ __forceinline__ void idx_select_row(const Params& p, const half_t* row, const int t, const int n, const int b,
                                               const int rowlen, const int NG, const int lane) {
        uint32_t one = 0x00010001u;
        asm volatile("" : "+v"(one));
        uint32_t kx[64];
#pragma unroll
        for (int g = 0; g < 16; ++g) {
          if (g < NGC && (g < NGC - 1 || NGC - 1 < NG)) {
            const u32x4 v = *(const u32x4*)(row + (g * 64 + lane) * 8);
#pragma unroll
            for (int i = 0; i < 4; ++i) {
              const uint32_t x = v[i];
              const uint32_t m = __builtin_bit_cast(uint32_t, __builtin_bit_cast(s16x2, x) >> 15);
              kx[4 * g + i] = x ^ (m | 0x80008000u);
            }
          } else {
#pragma unroll
            for (int i = 0; i < 4; ++i) kx[4 * g + i] = 0u;
          }
        }
        uint32_t sm4[4] = {0u, 0u, 0u, 0u};
#pragma unroll
        for (int g = 0; g < 16; ++g) {
          if (g < NGC) {
#pragma unroll
            for (int i = 0; i < 4; ++i) sm4[i] = pk_max(sm4[i], kx[4 * g + i]);
          }
        }
        const uint32_t mx = pk_max(pk_max(sm4[0], sm4[1]), pk_max(sm4[2], sm4[3]));
        const uint32_t mn = pk_min(pk_min(sm4[0], sm4[1]), pk_min(sm4[2], sm4[3]));
        int mxi = (int)max(mx & 0xffffu, mx >> 16);
        int mni = (int)min(mn & 0xffffu, mn >> 16);
        mxi = wave_max_dpp(mxi);
        mni = 0xffff - wave_max_dpp(0xffff - mni);
        uint32_t lo = (uint32_t)__builtin_amdgcn_readfirstlane(mni), hi = (uint32_t)__builtin_amdgcn_readfirstlane(mxi) + 1u;
        if (lo < 1u) lo = 1u;
        uint32_t candA, candB;
        {
          uint32_t e8[8];
#pragma unroll
          for (int i = 0; i < 4; ++i) {
            e8[2 * i] = sm4[i] & 0xffffu;
            e8[2 * i + 1] = sm4[i] >> 16;
          }
          CEX(e8[0], e8[2]); CEX(e8[1], e8[3]); CEX(e8[4], e8[6]); CEX(e8[5], e8[7]);
          CEX(e8[0], e8[4]); CEX(e8[1], e8[5]); CEX(e8[2], e8[6]); CEX(e8[3], e8[7]);
          CEX(e8[0], e8[1]); CEX(e8[2], e8[3]); CEX(e8[4], e8[5]); CEX(e8[6], e8[7]);
          CEX(e8[2], e8[4]); CEX(e8[3], e8[5]);
          CEX(e8[1], e8[4]); CEX(e8[3], e8[6]);
          CEX(e8[1], e8[2]); CEX(e8[3], e8[4]); CEX(e8[5], e8[6]);
          candB = (uint32_t)(wave_sum_dpp((int)e8[2]) + 32) >> 6;
          candA = (uint32_t)(wave_sum_dpp((int)e8[3]) + 32) >> 6;
        }
        int clo = 0, chi = 0;
        float flo = __log2f((float)(NG * 512)) - 8.0f, fhi = -9.0f;
        int side = 0, iter = 0;
        bool lo_probed = false;
#pragma unroll 1
        while (hi - lo > 1u) {
          uint32_t cand;
          if (iter >= 14) {
            cand = (lo + hi) >> 1;
          } else {
            const float tt = flo / (flo - fhi);
            cand = lo + (uint32_t)(tt * (float)(hi - lo) + 0.5f);
            if (iter == 0) cand = candA;
            if (iter == 1 && candB > lo && candB < hi) cand = candB;
            cand = min(max(cand, lo + 1u), hi - 1u);
          }
          cand = (uint32_t)__builtin_amdgcn_readfirstlane((int)cand);
          const uint32_t tm1 = cand - 1u;
          const uint32_t tx2 = tm1 | (tm1 << 16);
          int c;
          IDX_COUNTC(c, tx2);
          const float fc = __log2f((float)c + 0.5f) - 8.0f;
          if (c >= 256) {
            lo = cand;
            clo = c;
            lo_probed = true;
            if (c == 256) break;
            flo = fc;
            if (side == 1 && iter >= 2) fhi *= 0.5f;
            side = 1;
          } else {
            hi = cand;
            chi = c;
            fhi = fc;
            if (side == 2 && iter >= 2) flo *= 0.5f;
            side = 2;
          }
          ++iter;
        }
        if (!lo_probed) {
          const uint32_t tm1 = lo - 1u;
          const uint32_t tx2 = tm1 | (tm1 << 16);
          IDX_COUNTC(clo, tx2);
        }
        const uint32_t T = lo;
        const int cgt = chi, cge = clo;
        int need = 256 - cgt;
        const bool slow = (cge - cgt) > need;
        const uint32_t thr = slow ? (T + 1u) : T;
        const uint32_t thrx = thr | (thr << 16);
        const uint32_t tx = T | (T << 16);
        const uint32_t tm1x = (T - 1u) | ((T - 1u) << 16);
#pragma unroll
        for (int g = 0; g < 16; ++g) {
          if (g < NGC) {
            uint32_t b16[4];
#pragma unroll
            for (int i = 0; i < 4; ++i) b16[i] = pk_sub(0u, pk_min(pk_subsat(thrx, kx[4 * g + i]), one));
            uint32_t d0 = __builtin_amdgcn_perm(b16[1], b16[0], 0x06040200u) & 0x7E7E7E7Eu;
            uint32_t d1 = __builtin_amdgcn_perm(b16[3], b16[2], 0x06040200u) & 0x7E7E7E7Eu;
            if (slow) {
              uint32_t tb = 0;
#pragma unroll
              for (int i = 0; i < 4; ++i) {
                const uint32_t ge = pk_min(pk_subsat(kx[4 * g + i], tm1x), one);
                const uint32_t gt = pk_min(pk_subsat(kx[4 * g + i], tx), one);
                const uint32_t eq = ge - gt;
                tb |= ((eq & 1u) << (2 * i)) | (((eq >> 16) & 1u) << (2 * i + 1));
              }
              unsigned long long any = __ballot(tb != 0u);
              while (any && need > 0) {
                const int src = __ffsll((long long)any) - 1;
                any &= any - 1;
                uint32_t bits = (uint32_t)__builtin_amdgcn_readlane((int)tb, src);
                while (bits && need > 0) {
                  const int e = __ffs((int)bits) - 1;
                  bits &= bits - 1;
                  if (lane == src) {
                    if (e < 4) d0 &= ~(0xFFu << (8 * e));
                    else d1 &= ~(0xFFu << (8 * (e - 4)));
                  }
                  --need;
                }
              }
            }
            if ((g * 64 + lane) * 8 < rowlen) {
              uint8_t* tp = p.maskb() + mask_addr(b, t, g * 8 + (lane >> 3), lane & 7, 0);
              *(uint32_t*)tp = d0;
              *(uint32_t*)(tp + 512) = d1;
            }
          }
        }
}
#undef IDX_COUNTC

__device__ __forceinline__ void phase_index(const Params& p, half_t* sc, int bid, int nblk) {
  const int tid = TIDX, lane = tid & 63, wave = tid >> 6;
  const int half = lane >> 5, l31 = lane & 31;
  const float idx_scale = 0.125f * 0.35355339059327373f;
  half_t* scl = sc + half * 8192 + l31;
  const half_t hninf = (half_t)NEG_INF;
  half8 an[2][4];
  half8 nA[4], nB[4];
#define IDX_G(JJ) (4095 - ((JJ) * nblk + (((JJ) & 1) ? (nblk - 1 - bid) : bid)))
#define IDX_PREFETCH(GG)                                                                                         \
  {                                                                                                              \
    const int pg_ = (GG) >> 2, tb_ = ((GG) & 3) * SEQ, t0_ = pg_ * 8;                                            \
    _Pragma("unroll") for (int m = 0; m < 2; ++m) {                                                              \
      const int r = l31;                                                                                         \
      const int qq = 2 * (r >> 4) + ((r >> 2) & 1), hh = (r & 3) + 4 * ((r >> 3) & 1);                           \
      const half_t* ap = p.iq() + (size_t)(tb_ + t0_ + 4 * m + qq) * 512 + hh * 64 + half * 8;                   \
      _Pragma("unroll") for (int ks = 0; ks < 4; ++ks) an[m][ks] = *(const half8*)(ap + ks * 16);                \
    }                                                                                                            \
    const int nkt_ = ((t0_ + 7) >> 5) + 1;                                                                       \
    const int kB_ = (wave + NWAVE < nkt_) ? wave + NWAVE : wave;                                                 \
    const half_t* bpA = p.ik() + (size_t)((tb_ >> 5) + wave) * 2048 + lane * 8;                                  \
    const half_t* bpB = p.ik() + (size_t)((tb_ >> 5) + kB_) * 2048 + lane * 8;                                   \
    _Pragma("unroll") for (int ks = 0; ks < 4; ++ks) {                                                           \
      nA[ks] = *(const half8*)(bpA + ks * 512);                                                                  \
      nB[ks] = *(const half8*)(bpB + ks * 512);                                                                  \
    }                                                                                                            \
  }
  const int njj = (4096 + nblk - 1) / nblk;
  {
    int g0 = -1;
    for (int j = 0; j < njj && g0 < 0; ++j)
      if (IDX_G(j) >= 0) g0 = IDX_G(j);
    if (g0 < 0) return;
    IDX_PREFETCH(g0)
  }
  for (int jj = 0; jj < njj; ++jj) {
    const int G = IDX_G(jj);
    if (G < 0) continue;
    const int pgrp = G >> 2, b = G & 3;
    const int t0 = pgrp * 8, tokbase = b * SEQ;
    {
      half8 a[2][4];
      float wv[2][16];
#pragma unroll
      for (int m = 0; m < 2; ++m) {
#pragma unroll
        for (int ks = 0; ks < 4; ++ks) a[m][ks] = an[m][ks];
        const f32x4* w0 = (const f32x4*)(p.iw() + (size_t)(tokbase + t0 + 4 * m + half) * 8);
        const f32x4* w1 = (const f32x4*)(p.iw() + (size_t)(tokbase + t0 + 4 * m + 2 + half) * 8);
        const f32x4 wq0 = w0[0], wq1 = w0[1], wq2 = w1[0], wq3 = w1[1];
#pragma unroll
        for (int i = 0; i < 4; ++i) {
          wv[m][i] = wq0[i] * idx_scale;
          wv[m][4 + i] = wq1[i] * idx_scale;
          wv[m][8 + i] = wq2[i] * idx_scale;
          wv[m][12 + i] = wq3[i] * idx_scale;
        }
      }
      const int nkt = ((t0 + 7) >> 5) + 1;
      for (int kt = wave; kt < nkt; kt += 2 * NWAVE) {
        const bool has2 = (kt + NWAVE < nkt);
        const int sA = kt * 32, sB = has2 ? (kt + NWAVE) * 32 : sA;
        half8 bA[4], bB[4];
#pragma unroll
        for (int ks = 0; ks < 4; ++ks) {
          bA[ks] = nA[ks];
          bB[ks] = nB[ks];
        }
        {
          const int k2 = kt + 2 * NWAVE;
          const int kA2 = (k2 < nkt) ? k2 : kt;
          const int kB2 = (k2 + NWAVE < nkt) ? k2 + NWAVE : kA2;
          const half_t* bpA = p.ik() + (size_t)((tokbase >> 5) + kA2) * 2048 + lane * 8;
          const half_t* bpB = p.ik() + (size_t)((tokbase >> 5) + kB2) * 2048 + lane * 8;
#pragma unroll
          for (int ks = 0; ks < 4; ++ks) {
            nA[ks] = *(const half8*)(bpA + ks * 512);
            nB[ks] = *(const half8*)(bpB + ks * 512);
          }
        }
        __builtin_amdgcn_sched_barrier(0);
        f32x16 accA[2], accB[2];
#pragma unroll
        for (int m = 0; m < 2; ++m)
#pragma unroll
          for (int g = 0; g < 16; ++g) {
            accA[m][g] = 0.f;
            accB[m][g] = 0.f;
          }
#pragma unroll
        for (int ks = 0; ks < 4; ++ks)
#pragma unroll
          for (int m = 0; m < 2; ++m) {
            accA[m] = __builtin_amdgcn_mfma_f32_32x32x16_f16(a[m][ks], bA[ks], accA[m], 0, 0, 0);
            accB[m] = __builtin_amdgcn_mfma_f32_32x32x16_f16(a[m][ks], bB[ks], accB[m], 0, 0, 0);
          }
#pragma unroll
        for (int m = 0; m < 2; ++m) {
          f32x2 a_lo2 = {0.f, 0.f}, a_hi2 = {0.f, 0.f}, b_lo2 = {0.f, 0.f}, b_hi2 = {0.f, 0.f};
#pragma unroll
          for (int g = 0; g < 8; g += 2) {
            const f32x2 w2 = {wv[m][g], wv[m][g + 1]};
            a_lo2 += w2 * (f32x2){relu1(accA[m][g]), relu1(accA[m][g + 1])};
            b_lo2 += w2 * (f32x2){relu1(accB[m][g]), relu1(accB[m][g + 1])};
          }
#pragma unroll
          for (int g = 8; g < 16; g += 2) {
            const f32x2 w2 = {wv[m][g], wv[m][g + 1]};
            a_hi2 += w2 * (f32x2){relu1(accA[m][g]), relu1(accA[m][g + 1])};
            b_hi2 += w2 * (f32x2){relu1(accB[m][g]), relu1(accB[m][g + 1])};
          }
          const float a_lo = a_lo2[0] + a_lo2[1], a_hi = a_hi2[0] + a_hi2[1];
          const float b_lo = b_lo2[0] + b_lo2[1], b_hi = b_hi2[0] + b_hi2[1];
          const int qa = 4 * m + half, qb = 4 * m + 2 + half;
          const int keyA = sA + l31, keyB = sB + l31;
          half_t* scA = scl + (4 * m) * 8192 + sA;
          half_t* scB = scl + (4 * m) * 8192 + sB;
          if (sB + 31 <= t0) {
            scA[0] = (half_t)a_lo;
            scA[2 * 8192] = (half_t)a_hi;
            scB[0] = (half_t)b_lo;
            scB[2 * 8192] = (half_t)b_hi;
          } else {
            scA[0] = (keyA <= t0 + qa) ? (half_t)a_lo : hninf;
            scA[2 * 8192] = (keyA <= t0 + qb) ? (half_t)a_hi : hninf;
            if (has2) {
              scB[0] = (keyB <= t0 + qa) ? (half_t)b_lo : hninf;
              scB[2 * 8192] = (keyB <= t0 + qb) ? (half_t)b_hi : hninf;
            }
          }
        }
      }
      const int fill_lo = 32 * nkt, fill_hi = 512 * ((t0 + 8 + 511) >> 9);
#pragma unroll
      for (int q = 0; q < 8; ++q)
        for (int kk = fill_lo + tid; kk < fill_hi; kk += NTHR) sc[q * 8192 + kk] = hninf;
      {
        int gn = G;
        for (int j = jj + 1; j < njj; ++j)
          if (IDX_G(j) >= 0) {
            gn = IDX_G(j);
            break;
          }
        IDX_PREFETCH(gn)
      }
    }
    __syncthreads();
    {
      const int t = __builtin_amdgcn_readfirstlane(t0 + wave), n = t + 1;
      const int rowlen = 256 * ((t >> 8) + 1);
      const int NG = (n + 511) >> 9;
      const half_t* row = sc + wave * 8192;
      if (n <= 256) {
        const int l2 = TIDX & 63;
        uint32_t w = 0;
#pragma unroll
        for (int i = 0; i < 4; ++i)
          if (l2 * 4 + i >= n) w |= 0x7Eu << (8 * i);
        *(uint32_t*)(p.maskb() + mask_addr(b, t, l2 >> 4, (l2 & 15) >> 1, l2 & 1)) = w;
      } else {
        switch ((NG + 1) >> 1) {
          case 1: idx_select_row<2>(p, row, t, n, b, rowlen, NG, lane); break;
          case 2: idx_select_row<4>(p, row, t, n, b, rowlen, NG, lane); break;
          case 3: idx_select_row<6>(p, row, t, n, b, rowlen, NG, lane); break;
          case 4: idx_select_row<8>(p, row, t, n, b, rowlen, NG, lane); break;
          case 5: idx_select_row<10>(p, row, t, n, b, rowlen, NG, lane); break;
          case 6: idx_select_row<12>(p, row, t, n, b, rowlen, NG, lane); break;
          case 7: idx_select_row<14>(p, row, t, n, b, rowlen, NG, lane); break;
          default: idx_select_row<16>(p, row, t, n, b, rowlen, NG, lane); break;
        }
      }
    }
    __syncthreads();
  }
}

#define ATT_KROW 144
#define ATT_VROW 136
#define ATT_KBUF (64 * ATT_KROW)
#define ATT_VBUF (64 * ATT_VROW)
__device__ __forceinline__ void attn_unit(const Params& p, char* lds, int b, int head, int qb) {
  const int tid = TIDX, lane = tid & 63, wave = tid >> 6;
  const int r32 = lane & 31, hi = lane >> 5;
  const int tokbase = b * SEQ, q0 = qb * 256, q0w = q0 + wave * 32;
  const int ntiles = 4 * qb + 4;
  const int tlast = (q0w + 31) >> 6;
  char* Kb = lds;
  char* Vb = lds + 2 * ATT_KBUF;
  const int srow = tid >> 3, sch = tid & 7;
  const half_t* kg = p.k() + (size_t)(tokbase + srow) * 512 + head * 64 + sch * 8;
  const half_t* vg = p.vt() + ((size_t)((b * 8 + head) * 64 + srow)) * 8192 + sch * 8;
  const int klds = srow * ATT_KROW + sch * 16, vlds = srow * ATT_VROW + sch * 16;
  half8 qf[4];
  {
    const half_t* qp = p.q() + (size_t)(tokbase + q0w + r32) * 512 + head * 64 + hi * 8;
#pragma unroll
    for (int ks = 0; ks < 4; ++ks) qf[ks] = *(const half8*)(qp + ks * 16);
  }
  const uint8_t* mrow = p.maskb() + mask_unit(b, qb) + (size_t)wave * ntiles * 2048 + lane * 16;
  const char* kbl = Kb + r32 * ATT_KROW + hi * 16;
  const char* vbl = Vb + r32 * ATT_VROW + hi * 8;
  f32x16 ot0, ot1;
#pragma unroll
  for (int r = 0; r < 16; ++r) {
    ot0[r] = 0.f;
    ot1[r] = 0.f;
  }
  float ls0 = 0.f, ls1 = 0.f, ls2 = 0.f, ls3 = 0.f;
  half2v hones;
  hones[0] = (half_t)1.f;
  hones[1] = (half_t)1.f;

#define ATT_MASK_INIT(A0, A1, MA, MB)                                                          \
  _Pragma("unroll") for (int g = 0; g < 4; ++g) {                                             \
    const f32x2 a01 = __builtin_amdgcn_cvt_pk_f32_fp8((int)MA[g], false);                     \
    const f32x2 a23 = __builtin_amdgcn_cvt_pk_f32_fp8((int)MA[g], true);                      \
    const f32x2 b01 = __builtin_amdgcn_cvt_pk_f32_fp8((int)MB[g], false);                     \
    const f32x2 b23 = __builtin_amdgcn_cvt_pk_f32_fp8((int)MB[g], true);                      \
    A0[4 * g + 0] = a01[0];                                                                   \
    A0[4 * g + 1] = a01[1];                                                                   \
    A0[4 * g + 2] = a23[0];                                                                   \
    A0[4 * g + 3] = a23[1];                                                                   \
    A1[4 * g + 0] = b01[0];                                                                   \
    A1[4 * g + 1] = b01[1];                                                                   \
    A1[4 * g + 2] = b23[0];                                                                   \
    A1[4 * g + 3] = b23[1];                                                                   \
  }
#define ATT_QK(A0, A1, KB)                                                                    \
  _Pragma("unroll") for (int ks = 0; ks < 4; ++ks) {                                          \
    const half8 k0 = *(const half8*)((KB) + ks * 32);                                         \
    const half8 k1 = *(const half8*)((KB) + 32 * ATT_KROW + ks * 32);                         \
    A0 = __builtin_amdgcn_mfma_f32_32x32x16_f16(k0, qf[ks], A0, 0, 0, 0);                     \
    A1 = __builtin_amdgcn_mfma_f32_32x32x16_f16(k1, qf[ks], A1, 0, 0, 0);                     \
  }
#define ATT_SOFTMAX_ON(S0_, S1_, PB)                                                          \
  {                                                                                           \
    _Pragma("unroll") for (int r = 0; r < 16; r += 2) {                                       \
      const float e0 = __builtin_amdgcn_exp2f(-S0_[r]), e1 = __builtin_amdgcn_exp2f(-S1_[r]);   \
      const float e2 = __builtin_amdgcn_exp2f(-S0_[r + 1]), e3 = __builtin_amdgcn_exp2f(-S1_[r + 1]); \
      half2v h02, h13;                                                                        \
      h02[0] = (half_t)e0;                                                                    \
      h02[1] = (half_t)e2;                                                                    \
      h13[0] = (half_t)e1;                                                                    \
      h13[1] = (half_t)e3;                                                                    \
      if (r & 2) {                                                                            \
        ls2 = __builtin_amdgcn_fdot2(h02, hones, ls2, false);                                 \
        ls3 = __builtin_amdgcn_fdot2(h13, hones, ls3, false);                                 \
      } else {                                                                                \
        ls0 = __builtin_amdgcn_fdot2(h02, hones, ls0, false);                                 \
        ls1 = __builtin_amdgcn_fdot2(h13, hones, ls1, false);                                 \
      }                                                                                       \
      PB[r >> 3][r & 7] = h02[0];                                                             \
      PB[r >> 3][(r & 7) + 1] = h02[1];                                                       \
      PB[2 + (r >> 3)][r & 7] = h13[0];                                                       \
      PB[2 + (r >> 3)][(r & 7) + 1] = h13[1];                                                 \
    }                                                                                         \
  }
#define ATT_PV_ON(PB, VB)                                                                     \
  {                                                                                           \
    _Pragma("unroll") for (int s4 = 0; s4 < 4; ++s4) {                                        \
      const half4 x0 = *(const half4*)((VB) + s4 * 32);                                       \
      const half4 x1 = *(const half4*)((VB) + s4 * 32 + 16);                                  \
      const half4 y0 = *(const half4*)((VB) + 32 * ATT_VROW + s4 * 32);                       \
      const half4 y1 = *(const half4*)((VB) + 32 * ATT_VROW + s4 * 32 + 16);                  \
      half8 vf0, vf1;                                                                         \
      _Pragma("unroll") for (int i = 0; i < 4; ++i) {                                         \
        vf0[i] = x0[i];                                                                       \
        vf0[4 + i] = x1[i];                                                                   \
        vf1[i] = y0[i];                                                                       \
        vf1[4 + i] = y1[i];                                                                   \
      }                                                                                       \
      ot0 = __builtin_amdgcn_mfma_f32_32x32x16_f16(vf0, PB[s4], ot0, 0, 0, 0);                \
      ot1 = __builtin_amdgcn_mfma_f32_32x32x16_f16(vf1, PB[s4], ot1, 0, 0, 0);                \
    }                                                                                         \
  }

  u32x4 kA = *(const u32x4*)kg, vA = *(const u32x4*)vg;
  u32x4 mna, mnb, mXa, mXb;
  f32x16 s0, s1;
  const u32x4 m0a = *(const u32x4*)mrow, m0b = *(const u32x4*)(mrow + 1024);
  u32x4 kB = *(const u32x4*)(kg + (size_t)64 * 512);
  mna = *(const u32x4*)(mrow + 2048);
  mnb = *(const u32x4*)(mrow + 2048 + 1024);
  *(u32x4*)(Kb + klds) = kA;
  *(uint2*)(Vb + vlds) = make_uint2(vA[0], vA[1]);
  *(uint2*)(Vb + vlds + 8) = make_uint2(vA[2], vA[3]);
  *(u32x4*)(Kb + ATT_KBUF + klds) = kB;
  u32x4 vB = vA, mYa = m0a, mYb = m0b;
  asm volatile("s_waitcnt lgkmcnt(0)" ::: "memory");
  kA = *(const u32x4*)(kg + (size_t)2 * 64 * 512);
  vA = *(const u32x4*)(vg + 64);
  mXa = *(const u32x4*)(mrow + 2 * 2048);
  mXb = *(const u32x4*)(mrow + 2 * 2048 + 1024);
  {
    __syncthreads();
    ATT_MASK_INIT(s0, s1, m0a, m0b);
    ATT_QK(s0, s1, kbl);
    __syncthreads();
  }
#define ATT_STEP(T, KCUR, SC0, SC1, SN0, SN1, PW, PR, KH, VH, KL, VL, MHA, MHB, MLA, MLB)                     \
  {                                                                                                           \
    const int t = (T);                                                                                        \
    {                                                                                                         \
      const int tk = min(t + 3, ntiles - 1), tv = min(t + 2, ntiles - 1);   \
      KL = *(const u32x4*)(kg + (size_t)tk * 64 * 512);                                                       \
      MLA = *(const u32x4*)(mrow + tk * 2048);                                                                \
      MLB = *(const u32x4*)(mrow + tk * 2048 + 1024);                                                         \
      VL = *(const u32x4*)(vg + tv * 64);                                                                     \
    }                                                                                                         \
    const bool do_next = (t + 1 <= tlast) && (t + 1 < ntiles);                                                \
    const bool do_cur = (t <= tlast);                                                                         \
    const bool do_prev = (t >= 1) && (t - 1 <= tlast);                                                        \
    const char* vbp = vbl + vprev * ATT_VBUF;                                                      \
    if (do_next && do_cur && do_prev) {                                                                       \
      __builtin_amdgcn_s_setprio(1);                                                                          \
      ATT_MASK_INIT(SN0, SN1, mna, mnb);                                                                      \
      ATT_QK(SN0, SN1, kbl + ((KCUR) ^ 1) * ATT_KBUF);                                                        \
      ATT_SOFTMAX_ON(SC0, SC1, PW);                                                                           \
      ATT_PV_ON(PR, vbp);                                                                                     \
      __builtin_amdgcn_s_setprio(0);                                                                          \
    } else {                                                                                                  \
      if (do_next) {                                                                                          \
        ATT_MASK_INIT(SN0, SN1, mna, mnb);                                                                    \
        ATT_QK(SN0, SN1, kbl + ((KCUR) ^ 1) * ATT_KBUF);                                                      \
      }                                                                                                       \
      if (do_cur) ATT_SOFTMAX_ON(SC0, SC1, PW);                                                               \
      if (do_prev) ATT_PV_ON(PR, vbp);                                                                        \
    }                                                                                                         \
            \
    *(u32x4*)(Kb + (KCUR) * ATT_KBUF + klds) = KH;                                                            \
    *(uint2*)(Vb + vnext * ATT_VBUF + vlds) = make_uint2(VH[0], VH[1]);                                       \
    *(uint2*)(Vb + vnext * ATT_VBUF + vlds + 8) = make_uint2(VH[2], VH[3]);                                   \
    mna = MHA;                                                                                                \
    mnb = MHB;                                                                                                \
    vprev = (vprev == 2) ? 0 : vprev + 1;                                                                     \
    vnext = (vnext == 2) ? 0 : vnext + 1;                                                                     \
    __syncthreads();                                                                                          \
  }
  {
    f32x16 u0, u1;
    half8 pa[4], pb[4];
#pragma unroll
    for (int r = 0; r < 16; ++r) {
      u0[r] = 0.f;
      u1[r] = 0.f;
    }
#pragma unroll
    for (int q4 = 0; q4 < 4; ++q4)
#pragma unroll
      for (int j8 = 0; j8 < 8; ++j8) {
        pa[q4][j8] = (half_t)0.f;
        pb[q4][j8] = (half_t)0.f;
      }
    int vprev = 2, vnext = 1;
    for (int t2 = 0; t2 < ntiles; t2 += 2) {
      ATT_STEP(t2, 0, s0, s1, u0, u1, pa, pb, kA, vA, kB, vB, mXa, mXb, mYa, mYb)
      ATT_STEP(t2 + 1, 1, u0, u1, s0, s1, pb, pa, kB, vB, kA, vA, mYa, mYb, mXa, mXb)
    }
    if (tlast == ntiles - 1) {
      ATT_PV_ON(pb, vbl + vprev * ATT_VBUF);
    }
    __syncthreads();
  }
#undef ATT_STEP
#undef ATT_MASK_INIT
#undef ATT_QK
#undef ATT_SOFTMAX_ON
#undef ATT_PV_ON
  float lsum = (ls0 + ls1) + (ls2 + ls3);
  lsum += __shfl_xor(lsum, 32);
  const float inv = 1.f / lsum;
  half_t* op = p.yattn() + (size_t)(tokbase + q0w + r32) * 512 + head * 64 + hi * 4;
#pragma unroll
  for (int g = 0; g < 4; ++g) {
    half4 o0, o1;
#pragma unroll
    for (int i = 0; i < 4; ++i) {
      o0[i] = (half_t)(ot0[4 * g + i] * inv);
      o1[i] = (half_t)(ot1[4 * g + i] * inv);
    }
    *(half4*)(op + 8 * g) = o0;
    *(half4*)(op + 32 + 8 * g) = o1;
  }
}

__device__ __forceinline__ void phase_attn(const Params& p, char* lds, int bid, int nblk) {
  for (int task = bid; task < 512; task += nblk) {
    const int bh = task & 31, pq = task >> 5;
    attn_unit(p, lds, bh >> 3, bh & 7, 31 - pq);
    attn_unit(p, lds, bh >> 3, bh & 7, pq);
  }
}

__device__ __forceinline__ void phase_ymix(const Params& p, int bid, int nblk) {
  const int lane = TIDX & 63, wave = TIDX >> 6;
  for (int tok = bid * NWAVE + wave; tok < T_TOK; tok += nblk * NWAVE) {
    const int pos = tok & 8191;
    const int c0 = lane * 8;
    {
      const half8 ya = *(const half8*)(p.yattn() + (size_t)tok * 512 + c0);
      float f[8], ss = 0.f;
#pragma unroll
      for (int i = 0; i < 8; ++i) {
        f[i] = (float)ya[i];
        ss += f[i] * f[i];
      }
      ss = wave_sum(ss);
      const float rs = rsqrtf(ss * (1.f / 512.f) + 1e-6f);
      half8 o;
#pragma unroll
      for (int i = 0; i < 8; ++i) o[i] = (half_t)(f[i] * rs * p.attn_out_norm_w[c0 + i]);
      *(half8*)(p.ymix() + (size_t)tok * 1024 + c0) = o;
    }
    {
      const half8 u0 = *(const half8*)(p.uu() + (size_t)tok * 512 + c0);
      half8 u1, u2;
#pragma unroll
      for (int i = 0; i < 8; ++i) {
        u1[i] = (half_t)0.f;
        u2[i] = (half_t)0.f;
      }
      if (pos >= 1) u1 = *(const half8*)(p.uu() + (size_t)(tok - 1) * 512 + c0);
      if (pos >= 2) u2 = *(const half8*)(p.uu() + (size_t)(tok - 2) * 512 + c0);
      const half8 cbv = *(const half8*)(p.cb() + (size_t)tok * 512 + c0);
      float y[8], ss = 0.f;
#pragma unroll
      for (int i = 0; i < 8; ++i) {
        const int c = c0 + i;
        float acc = p.conv_b[c] + p.conv_w[c] * (float)u2[i] + p.conv_w[512 + c] * (float)u1[i] +
                    p.conv_w[1024 + c] * (float)u0[i];
        y[i] = (float)cbv[i] * acc;
        ss += y[i] * y[i];
      }
      ss = wave_sum(ss);
      const float rs = rsqrtf(ss * (1.f / 512.f) + 1e-6f);
      half8 o;
#pragma unroll
      for (int i = 0; i < 8; ++i) o[i] = (half_t)(y[i] * rs * p.conv_out_norm_w[c0 + i]);
      *(half8*)(p.ymix() + (size_t)tok * 1024 + 512 + c0) = o;
    }
  }
}


#define XB_TMO      128
#define XB_XCNT(j)  (256  + 64 * (j))
#define XB_XSUB(j)  (1280 + 64 * (j))
#define XB_XGEN(j)  (2304 + 64 * (j))
#define XB_TOP      3328
#define XB_TOPGEN   3392
#define XCD_BAR_WORDS 3456
#define XB_SPIN_CAP (1u << 22)
__device__ __forceinline__ unsigned xb_ld(unsigned* p) { return __hip_atomic_load(p, __ATOMIC_RELAXED, __HIP_MEMORY_SCOPE_AGENT); }
__device__ __forceinline__ unsigned xb_add(unsigned* p, unsigned v) { return __hip_atomic_fetch_add(p, v, __ATOMIC_RELAXED, __HIP_MEMORY_SCOPE_AGENT); }
__device__ __forceinline__ unsigned xb_xcc_id() { return (unsigned)__builtin_amdgcn_s_getreg((3 << 11) | 20) & 0xFu; }
#define XB_SPIN(cond, bar) do { unsigned _sp = 0; while (cond) { __builtin_amdgcn_s_sleep(1); \
    if ((++_sp & 255u) == 0u) { if (xb_ld(&(bar)[XB_TMO])) break; if (_sp > XB_SPIN_CAP) { atomicAdd(&(bar)[XB_TMO], 1u); break; } } } } while (0)
__device__ __forceinline__ void xcd_barrier_post(unsigned* bar, volatile LAS unsigned* st) {
  if (TIDX == 0) {
    const unsigned x = xb_xcc_id();
    st[0] = 0u;
    st[1] = 0u;
    st[2] = x;
    st[3] = xb_add(&bar[XB_XCNT(x)], 1u);
  }
}
__device__ __forceinline__ void xcd_barrier_complete(unsigned* bar, unsigned x, unsigned& nloc, unsigned& nx) {
  const unsigned G = gridDim.x * gridDim.y * gridDim.z;
  unsigned sum, cnt, mine, sp = 0u;
  for (;;) {
    sum = 0u; cnt = 0u; mine = 0u;
#pragma unroll
    for (unsigned j = 0; j < 16; ++j) { const unsigned c = xb_ld(&bar[XB_XCNT(j)]); sum += c; cnt += (c > 0u) ? 1u : 0u; mine = (j == x) ? c : mine; }
    if (sum == G) break;
    __builtin_amdgcn_s_sleep(1);
    if ((++sp & 255u) == 0u) { if (xb_ld(&bar[XB_TMO])) break; if (sp > XB_SPIN_CAP) { atomicAdd(&bar[XB_TMO], 1u); break; } }
  }
  nloc = mine > 0u ? mine : 1u;
  nx = cnt > 0u ? cnt : 1u;
}
__device__ __forceinline__ void xcd_barrier(unsigned* bar, volatile LAS unsigned* st) {
  asm volatile("s_waitcnt vmcnt(0)" ::: "memory");
  __syncthreads();
  if (TIDX == 0) {
    __builtin_amdgcn_s_waitcnt(0);
    unsigned nloc = st[0], nx = st[1];
    const unsigned x = st[2];
    if (nloc == 0u) { xcd_barrier_complete(bar, x, nloc, nx); st[0] = nloc; st[1] = nx; }
    const unsigned old = xb_add(&bar[XB_XSUB(x)], 1u);
    const unsigned gen = old / nloc;
    if (old + 1u == (gen + 1u) * nloc) {
      __builtin_amdgcn_fence(__ATOMIC_RELEASE, "agent");
      asm volatile("s_waitcnt vmcnt(0)" ::: "memory");
      const unsigned og = xb_add(&bar[XB_TOP], 1u);
      const unsigned tg = og / nx;
      if (og + 1u == (tg + 1u) * nx) xb_add(&bar[XB_TOPGEN], 1u);
      else XB_SPIN(xb_ld(&bar[XB_TOPGEN]) == tg, bar);
      __builtin_amdgcn_fence(__ATOMIC_ACQUIRE, "agent");
      xb_add(&bar[XB_XGEN(x)], 1u);
      asm volatile("s_waitcnt vmcnt(0)" ::: "memory");
    } else {
      XB_SPIN(xb_ld(&bar[XB_XGEN(x)]) == gen, bar);
      __builtin_amdgcn_fence(__ATOMIC_ACQUIRE, "agent");
      asm volatile("s_waitcnt vmcnt(0)" ::: "memory");
    }
  }
  __syncthreads();
}

struct SliceSched {
  int nloc, rank, myord, npop;
};
__device__ __forceinline__ SliceSched slice_sched(unsigned* bar, volatile LAS unsigned* st) {
  SliceSched r;
  const unsigned x = st[2];
  int npop = 0, myord = 0, nloc = 1;
  for (unsigned j = 0; j < 16; ++j) {
    const unsigned c = xb_ld(&bar[XB_XCNT(j)]);
    if (j == x) {
      myord = npop;
      nloc = (int)c;
    }
    npop += (c > 0u) ? 1 : 0;
  }
  r.nloc = __builtin_amdgcn_readfirstlane(nloc);
  r.rank = __builtin_amdgcn_readfirstlane((int)st[3]);
  r.myord = __builtin_amdgcn_readfirstlane(myord);
  r.npop = __builtin_amdgcn_readfirstlane(npop);
  return r;
}

__device__ __forceinline__ void sort16_desc(uint32_t (&x)[16]) {
  CEX(x[0], x[13]); CEX(x[1], x[12]); CEX(x[2], x[15]); CEX(x[3], x[14]); CEX(x[4], x[8]); CEX(x[5], x[6]); CEX(x[7], x[11]); CEX(x[9], x[10]);
  CEX(x[0], x[5]); CEX(x[1], x[7]); CEX(x[2], x[9]); CEX(x[3], x[4]); CEX(x[6], x[13]); CEX(x[8], x[14]); CEX(x[10], x[15]); CEX(x[11], x[12]);
  CEX(x[0], x[1]); CEX(x[2], x[3]); CEX(x[4], x[5]); CEX(x[6], x[8]); CEX(x[7], x[9]); CEX(x[10], x[11]); CEX(x[12], x[13]); CEX(x[14], x[15]);
  CEX(x[0], x[2]); CEX(x[1], x[3]); CEX(x[4], x[10]); CEX(x[5], x[11]); CEX(x[6], x[7]); CEX(x[8], x[9]); CEX(x[12], x[14]); CEX(x[13], x[15]);
  CEX(x[1], x[2]); CEX(x[3], x[12]); CEX(x[4], x[6]); CEX(x[5], x[7]); CEX(x[8], x[10]); CEX(x[9], x[11]); CEX(x[13], x[14]);
  CEX(x[1], x[4]); CEX(x[2], x[6]); CEX(x[5], x[8]); CEX(x[7], x[10]); CEX(x[9], x[13]); CEX(x[11], x[14]);
  CEX(x[2], x[4]); CEX(x[3], x[6]); CEX(x[9], x[12]); CEX(x[11], x[13]);
  CEX(x[3], x[5]); CEX(x[6], x[8]); CEX(x[7], x[9]); CEX(x[10], x[12]);
  CEX(x[3], x[4]); CEX(x[5], x[6]); CEX(x[7], x[8]); CEX(x[9], x[10]); CEX(x[11], x[12]);
  CEX(x[6], x[7]); CEX(x[8], x[9]);
}
__device__ __forceinline__ void merge16_desc(uint32_t (&t)[16], const uint32_t (&x)[16]) {
#pragma unroll
  for (int i = 0; i < 16; ++i) t[i] = max(t[i], x[15 - i]);
#pragma unroll
  for (int j = 8; j >= 1; j >>= 1) {
#pragma unroll
    for (int i = 0; i < 16; ++i) {
      const int pnr = i ^ j;
      if (pnr > i) CEX(t[i], t[pnr]);
    }
  }
}
__device__ __forceinline__ uint32_t f2key(float f) {
  uint32_t u = __float_as_uint(f);
  return (u & 0x80000000u) ? ~u : (u | 0x80000000u);
}
__device__ __forceinline__ float hkey2f(uint32_t k) {
  const uint32_t c = k >> 16;
  const uint16_t h = (uint16_t)((c & 0x8000u) ? (c ^ 0x8000u) : ~c);
  return (float)__builtin_bit_cast(half_t, h);
}
__device__ __forceinline__ float key2f(uint32_t k) {
  uint32_t u = (k & 0x80000000u) ? (k & 0x7fffffffu) : ~k;
  return __uint_as_float(u);
}

__device__ __forceinline__ void phase_topk(const Params& p, uint32_t* sm, int bid, int nblk) {
  const int lane = TIDX & 63, wave = TIDX >> 6;
  uint32_t* mytab = sm + (wave * 64 + lane) * 27;
  for (int tg = bid * NWAVE + wave; tg < T_TOK / 4; tg += nblk * NWAVE) {
    const int tok = tg * 4 + (lane >> 4), hp = lane & 15;
    const half_t* row = p.ps() + (size_t)tok * 2048 + hp * 128;
    uint32_t t[16];
#pragma unroll
    for (int grp = 0; grp < 8; ++grp) {
      const u32x4 a = *(const u32x4*)(row + grp * 16), b = *(const u32x4*)(row + grp * 16 + 8);
      uint32_t x[16];
#pragma unroll
      for (int i = 0; i < 4; ++i) {
        const uint32_t wa = a[i], wb = b[i];
        const uint32_t ka = wa ^ (__builtin_bit_cast(uint32_t, __builtin_bit_cast(s16x2, wa) >> 15) | 0x80008000u);
        const uint32_t kb = wb ^ (__builtin_bit_cast(uint32_t, __builtin_bit_cast(s16x2, wb) >> 15) | 0x80008000u);
        x[2 * i] = (ka << 16) | (uint32_t)(grp * 16 + 2 * i);
        x[2 * i + 1] = (ka & 0xffff0000u) | (uint32_t)(grp * 16 + 2 * i + 1);
        x[8 + 2 * i] = (kb << 16) | (uint32_t)(grp * 16 + 8 + 2 * i);
        x[8 + 2 * i + 1] = (kb & 0xffff0000u) | (uint32_t)(grp * 16 + 8 + 2 * i + 1);
      }
      sort16_desc(x);
      if (grp == 0) {
#pragma unroll
        for (int i = 0; i < 16; ++i) t[i] = x[i];
      } else {
        merge16_desc(t, x);
      }
    }
    float v0[16], v1[16];
    uint32_t i0[16], i1[16];
#pragma unroll
    for (int i = 0; i < 16; ++i) {
      const uint32_t o = (uint32_t)__builtin_amdgcn_update_dpp(0, (int)t[i], 0xB1, 0xF, 0xF, true);
      const uint32_t k0 = (lane & 1) ? o : t[i], k1 = (lane & 1) ? t[i] : o;
      v0[i] = hkey2f(k0);
      v1[i] = hkey2f(k1);
      i0[i] = k0 & 127u;
      i1[i] = k1 & 127u;
    }
    uint32_t c[4][16];
    uint32_t eidtab[64];
    {
      int slot = 0;
#pragma unroll
      for (int i = 0; i < 16; ++i) {
#pragma unroll
        for (int j = 0; j < 16; ++j) {
          if ((i + 1) * (j + 1) <= 16) {
            c[slot >> 4][slot & 15] = (f2key(v0[i] + v1[j]) & ~63u) | (uint32_t)slot;
            eidtab[slot] = i0[i] * 128u + i1[j];
            ++slot;
          }
        }
      }
#pragma unroll
      for (; slot < 64; ++slot) {
        c[slot >> 4][slot & 15] = 0u;
        eidtab[slot] = 0u;
      }
    }
#pragma unroll
    for (int s2 = 0; s2 < 26; ++s2) mytab[s2] = eidtab[2 * s2] | (eidtab[2 * s2 + 1] << 16);
    sort16_desc(c[0]);
    sort16_desc(c[1]);
    sort16_desc(c[2]);
    sort16_desc(c[3]);
    merge16_desc(c[0], c[1]);
    merge16_desc(c[2], c[3]);
    merge16_desc(c[0], c[2]);
    float sv[16], den = 0.f;
    const float mx = key2f(c[0][0] & ~63u);
#pragma unroll
    for (int r = 0; r < 16; ++r) {
      sv[r] = __expf(key2f(c[0][r] & ~63u) - mx);
      den += sv[r];
    }
    const float rden = 1.f / den;
    if ((lane & 1) == 0) {
      const int head = hp >> 1;
      uint32_t ew[8];
      f32x4 gv[4];
#pragma unroll
      for (int r = 0; r < 16; ++r) {
        const uint32_t slot = c[0][r] & 63u;
        const uint32_t pr = mytab[slot >> 1];
        const uint32_t e16 = (slot & 1) ? (pr >> 16) : (pr & 0xffffu);
        if (r & 1) ew[r >> 1] |= e16 << 16;
        else ew[r >> 1] = e16;
        gv[r >> 2][r & 3] = sv[r] * rden;
      }
      u32x4* eo = (u32x4*)(p.eid() + (size_t)tok * 128 + head * 16);
      f32x4* go = (f32x4*)(p.gw() + (size_t)tok * 128 + head * 16);
      eo[0] = (u32x4){ew[0], ew[1], ew[2], ew[3]};
      eo[1] = (u32x4){ew[4], ew[5], ew[6], ew[7]};
#pragma unroll
      for (int q = 0; q < 4; ++q) go[q] = gv[q];
    }
  }
}

__device__ __forceinline__ float gelu_tanh(float x) {
  const float z = 0.7978845608028654f * (x + 0.044715f * x * x * x);
  const float e = __expf(2.f * z);
  const float th = 1.f - 2.f / (e + 1.f);
  return 0.5f * x * (1.f + th);
}

__device__ __forceinline__ int red8_dpp(int v) {
  v += __builtin_amdgcn_update_dpp(0, v, 0x141, 0xF, 0xF, true);
  v += __builtin_amdgcn_update_dpp(0, v, 0xB1, 0xF, 0xF, true);
  v += __builtin_amdgcn_update_dpp(0, v, 0x4E, 0xF, 0xF, true);
  return v;
}

#define PU_WDW 1032
#define PU_ISSUE(S, SLOT, NN, BB, TOKV)                                                              \
  {                                                                                                  \
    const int idx_ = (BB) * 8 + grp;                                                                 \
    val##S = idx_ < (NN);                                                                            \
    const uint32_t ent_ = val##S ? lst[(SLOT) * 128 + idx_] : 0u;                                    \
    gg##S = val##S ? lstg[(SLOT) * 128 + idx_] : 0.f;                                                \
    const uint32_t e_ = ent_ & 0xffffu;                                                              \
    cp##S = val##S ? (p.coef() + (size_t)(TOKV) * 128 + (ent_ >> 16)) : dummy;                       \
    const int8_t* rp_ = ub + (size_t)(e_ >> 3) * 1024;                                               \
    _Pragma("unroll") for (int st = 0; st < 8; ++st) w##S[st] = *(const u32x4*)(rp_ + st * 128);    \
    us##S = p.uscale()[e_];                                                                          \
  }
#define PU_FIN(S)                                                                                    \
  {                                                                                                  \
    int d = 0;                                                                                       \
    _Pragma("unroll") for (int st = 0; st < 8; ++st)                                                 \
      _Pragma("unroll") for (int c = 0; c < 4; ++c)                                                  \
        d = __builtin_amdgcn_sdot4((int)w##S[st][c], (int)hqC[st][c], d, false);                     \
    d = red8_dpp(d);                                                                                 \
    *cp##S = gg##S * gelu_tanh((float)d * us##S * hsC);                                              \
  }
#define PU_STAGE(SLOT, NOUT)                                                                         \
  {                                                                                                  \
    const bool ina_ = (m_ea & 7u) == (uint32_t)x, inb_ = (m_eb & 7u) == (uint32_t)x;                 \
    const unsigned long long ba_ = __ballot(ina_), bb_ = __ballot(inb_);                             \
    const int ca_ = __popcll(ba_);                                                                   \
    NOUT = ca_ + __popcll(bb_);                                                                      \
    if (ina_) {                                                                                      \
      const int q_ = (SLOT) * 128 + __popcll(ba_ & lmask);                                           \
      lst[q_] = m_ea | ((uint32_t)lane << 16);                                                       \
      lstg[q_] = m_ga;                                                                               \
    }                                                                                                \
    if (inb_) {                                                                                      \
      const int q_ = (SLOT) * 128 + ca_ + __popcll(bb_ & lmask);                                     \
      lst[q_] = m_eb | ((uint32_t)(64 + lane) << 16);                                                \
      lstg[q_] = m_gb;                                                                               \
    }                                                                                                \
    *(u32x4*)(hrow + (SLOT) * 256 + lane * 4) = m_h;                                                 \
    if (lane == 0) hsv[SLOT] = m_hs;                                                                 \
    asm volatile("s_waitcnt lgkmcnt(0)" ::: "memory");                                              \
  }
#define PU_TOK(i) (tok0 + min((i), ntok - 1) * tstride)
#define PU_FETCH(TI)                                                                                 \
  {                                                                                                  \
    const int t_ = PU_TOK(TI);                                                                       \
    m_ea = p.eid()[(size_t)t_ * 128 + lane];                                                         \
    m_eb = p.eid()[(size_t)t_ * 128 + 64 + lane];                                                    \
    m_ga = p.gw()[(size_t)t_ * 128 + lane];                                                          \
    m_gb = p.gw()[(size_t)t_ * 128 + 64 + lane];                                                     \
    m_h = *(const u32x4*)(p.h2q() + (size_t)t_ * 1024 + lane * 16);                                  \
    m_hs = p.hscale()[t_];                                                                           \
  }
#define PU_LOADH(SLOT)                                                                               \
  {                                                                                                  \
    _Pragma("unroll") for (int st = 0; st < 8; ++st) hqC[st] = *(const u32x4*)(hrow + (SLOT) * 256 + st * 32 + sub * 4); \
    hsC = hsv[SLOT];                                                                                 \
  }
#define PU_TOKEN(TI, SL, X, Y)                                                                       \
  {                                                                                                  \
    const int tokC = PU_TOK(TI), tokN = PU_TOK((TI) + 1);                                            \
    PU_STAGE((SL) ^ 1, n_nxt);                                                                       \
    PU_FETCH((TI) + 2)                                                                               \
    PU_ISSUE(Y, SL, n_cur, 1, tokC)                                                                  \
    PU_FIN(X)                                                                                        \
    PU_ISSUE(X, SL, n_cur, 2, tokC)                                                                  \
    PU_FIN(Y)                                                                                        \
    PU_ISSUE(Y, (SL) ^ 1, n_nxt, 0, tokN)                                                            \
    PU_FIN(X)                                                                                        \
    for (int bx = 3; bx * 8 < n_cur; ++bx) {                                                         \
      PU_ISSUE(X, SL, n_cur, bx, tokC)                                                               \
      PU_FIN(X)                                                                                      \
    }                                                                                                \
    PU_LOADH((SL) ^ 1)                                                                               \
    n_cur = n_nxt;                                                                                   \
  }
__device__ __forceinline__ void phase_peer_u(const Params& p, uint32_t* sm, const int x, const int rank, const int nper) {
  const int lane = TIDX & 63, wave = TIDX >> 6;
  const int grp = lane >> 3, sub = lane & 7;
  uint32_t* lst = sm + wave * PU_WDW;
  float* lstg = (float*)(lst + 256);
  uint32_t* hrow = lst + 512;
  float* hsv = (float*)(lst + 1024);
  const int8_t* ub = p.pu8() + (size_t)x * 2048 * 1024 + sub * 16;
  const unsigned long long lmask = (1ull << lane) - 1ull;
  const int tstride = nper * NWAVE;
  const int tok0 = rank * NWAVE + wave;
  if (tok0 >= T_TOK) return;
  const int ntok = (T_TOK - tok0 + tstride - 1) / tstride;
  float* dummy = (float*)p.v() + ((size_t)blockIdx.x * NTHR + TIDX);
  u32x4 wA[8], wB[8];
  bool valA = false, valB = false;
  float* cpA = dummy;
  float* cpB = dummy;
  float usA = 0.f, usB = 0.f, ggA = 0.f, ggB = 0.f;
  u32x4 hqC[8];
  float hsC;
  uint32_t m_ea, m_eb;
  float m_ga, m_gb, m_hs;
  u32x4 m_h;
  int n_cur, n_nxt = 0;
  PU_FETCH(0)
  PU_STAGE(0, n_cur);
  PU_FETCH(1)
  PU_LOADH(0)
  PU_ISSUE(A, 0, n_cur, 0, tok0)
  asm volatile("s_waitcnt vmcnt(0)" ::: "memory");
#pragma unroll 1
  for (int ti = 0; ti < ntok; ti += 2) {
    PU_TOKEN(ti, 0, A, B)
    PU_TOKEN(ti + 1, 1, B, A)
  }
}
#undef PU_ISSUE
#undef PU_FIN
#undef PU_STAGE
#undef PU_FETCH
#undef PU_LOADH
#undef PU_TOKEN
#undef PU_TOK

__device__ __forceinline__ void phase_peer_v(const Params& p, const int x, const int rank, const int nper) {
  typedef unsigned u32x2 __attribute__((ext_vector_type(2)));
  const int lane = TIDX & 63, wave = TIDX >> 6;
  const int pg = lane >> 3, ch = lane & 7;
  const uint8_t* vb = p.pv8() + (size_t)x * 16384 * 128 + ch * 16;
  const int tstride = nper * NWAVE;
  const int tok0 = rank * NWAVE + wave;
  if (tok0 >= T_TOK) return;
  const int ntok = (T_TOK - tok0 + tstride - 1) / tstride;
  const int dd = x * 128 + ch * 16 + 4 * ((lane >> 4) & 1) + 8 * (lane >> 5);
  float* dummy = (float*)p.v() + ((size_t)blockIdx.x * NTHR + TIDX) * 4;
#define PV_TOK(i) (tok0 + min((i), ntok - 1) * tstride)
#define PV_LOAD_IDS(E, i)                                                              \
  {                                                                                    \
    const u32x4* ep = (const u32x4*)(p.eid() + (size_t)PV_TOK(i) * 128 + pg * 16);     \
    E[0] = ep[0];                                                                      \
    E[1] = ep[1];                                                                      \
  }
#define PV_LOAD_COEF(C, i)                                                             \
  {                                                                                    \
    const f32x4* cp = (const f32x4*)(p.coef() + (size_t)PV_TOK(i) * 128 + pg * 16);    \
    _Pragma("unroll") for (int q = 0; q < 4; ++q) C[q] = cp[q];                        \
  }
#define PV_ROWS(W, E)                                                                  \
  _Pragma("unroll") for (int it = 0; it < 16; ++it) {                                  \
    const uint32_t e = (E[it >> 3][(it >> 1) & 3] >> (16 * (it & 1))) & 0xffffu;       \
    W[it] = *(const u32x4*)(vb + (size_t)e * 128);                                     \
  }
#define PV_STEP(I, WC, EC, CC, WN, EN)                                                                                 \
  {                                                                                                                    \
    const int tok = PV_TOK(I);                                                                                         \
    PV_LOAD_IDS(EC, (I) + 2)                                                                                           \
    float* op = p.out + (size_t)tok * 1024 + dd;                                                                       \
    const f32x4 x1 = *(const f32x4*)op;                                                                                \
    const f32x4 gt = *(const f32x4*)(p.mod() + (tok >> 13) * 6144 + 5120 + dd);                                       \
    __builtin_amdgcn_sched_barrier(0);     \
    PV_ROWS(WN, EN)                                                                                                    \
    __builtin_amdgcn_sched_barrier(0);                                                                                 \
    f32x2 acc[8];                                                                                                      \
    _Pragma("unroll") for (int i = 0; i < 8; ++i) acc[i] = (f32x2){0.f, 0.f};                                          \
    _Pragma("unroll") for (int it = 0; it < 16; ++it) {                                                                \
      const float cfi = CC[it >> 2][it & 3];                                                                           \
      const f32x2 c2 = (f32x2){cfi, cfi};                                                                              \
      _Pragma("unroll") for (int d = 0; d < 4; ++d) {                                                                  \
        const f32x2 lo = __builtin_amdgcn_cvt_pk_f32_fp8((int)WC[it][d], false);                                       \
        const f32x2 hi = __builtin_amdgcn_cvt_pk_f32_fp8((int)WC[it][d], true);                                        \
        acc[d * 2 + 0] += c2 * lo;                                                                                     \
        acc[d * 2 + 1] += c2 * hi;                                                                                     \
      }                                                                                                                \
    }                                                                                                                  \
             \
    float a16[16];                                                                                                     \
    _Pragma("unroll") for (int i = 0; i < 8; ++i) {                                                                    \
      a16[2 * i] = acc[i][0];                                                                                          \
      a16[2 * i + 1] = acc[i][1];                                                                                      \
    }                                                                                                                  \
    float s1[8];                                                                                                       \
    _Pragma("unroll") for (int i = 0; i < 8; ++i) {                                                                    \
      const u32x2 r = __builtin_amdgcn_permlane32_swap(__float_as_uint(a16[i]), __float_as_uint(a16[i + 8]), false, false); \
      s1[i] = __uint_as_float(r[0]) + __uint_as_float(r[1]);            \
    }                                                                                                                  \
    float s2[4];                                                                                                       \
    _Pragma("unroll") for (int i = 0; i < 4; ++i) {                                                                    \
      const u32x2 r = __builtin_amdgcn_permlane16_swap(__float_as_uint(s1[i]), __float_as_uint(s1[i + 4]), false, false); \
      s2[i] = __uint_as_float(r[0]) + __uint_as_float(r[1]);      \
    }                                                                                                                  \
    f32x4 o;                                                                                                           \
    _Pragma("unroll") for (int i = 0; i < 4; ++i) {                                                                    \
      const float t8 = __uint_as_float((unsigned)__builtin_amdgcn_update_dpp(0, (int)__float_as_uint(s2[i]), 0x128, 0xF, 0xF, true)); \
      o[i] = x1[i] + gt[i] * (s2[i] + t8) * (1.f / 128.f);                                                             \
    }                                                                                                                  \
      \
    *(f32x4*)(((I) < ntok) ? op : dummy) = o;                                                                          \
    PV_LOAD_COEF(CC, (I) + 2)                                                                                          \
  }
  u32x4 eA[2], eB[2], wA[16], wB[16];
  f32x4 cA[4], cB[4];
  PV_LOAD_IDS(eA, 0)
  PV_LOAD_COEF(cA, 0)
  PV_LOAD_IDS(eB, 1)
  PV_LOAD_COEF(cB, 1)
  PV_ROWS(wA, eA)
  asm volatile("s_waitcnt vmcnt(0)" ::: "memory");
#pragma unroll 1
  for (int i = 0; i < ntok; i += 2) {
    PV_STEP(i, wA, eA, cA, wB, eB)
    PV_STEP(i + 1, wB, eB, cB, wA, eA)
  }
#undef PV_TOK
#undef PV_LOAD_IDS
#undef PV_LOAD_COEF
#undef PV_ROWS
#undef PV_STEP
}

namespace cg = cooperative_groups;
__global__ __launch_bounds__(NTHR) void fwd_megakernel(Params p) {
  __shared__ __attribute__((aligned(16))) char smem[131072 + 16];
#define xb_words (*(uint4*)(smem + 131072))
  cg::grid_group grid = cg::this_grid();
  xcd_barrier_post(p.bar(), (volatile LAS unsigned*)&xb_words);
  __syncthreads();
  const int bid = blockIdx.x, nblk = gridDim.x;
  float* smf = (float*)smem;
  half_t* smh = (half_t*)smem;
  prep_ada(p, smf, bid, nblk);
  __syncthreads();
  prep_transpose<true>(p.w_in, p.wt_in(), DIN, DINP, smf, bid, nblk);
  prep_transpose<false>(p.w_out, p.wt_out(), 1024, 1024, smf, bid, nblk);
  prep_wprime(p, smf, bid, nblk);
  if (p.ws == nullptr) grid.sync();
  xcd_barrier(p.bar(), (volatile LAS unsigned*)&xb_words);
  phase_norm_mod<false>(p.x, p.norm1_w, p.mod(), 0, 1024, p.h(), nullptr, nullptr, bid, nblk);
  xcd_barrier(p.bar(), (volatile LAS unsigned*)&xb_words);
  {
    EpiIn e{p};
    phase_gemm(p.h(), p.wt_in(), 15, smh, e, bid, nblk);
  }
  {
    const int full = (128 * 15) / nblk, rem = (128 * 15) % nblk;
    if (rem == 0) prep_tables(p, bid, nblk);
    else if (bid >= rem) prep_tables(p, bid - rem, nblk - rem);
    (void)full;
  }
  xcd_barrier(p.bar(), (volatile LAS unsigned*)&xb_words);
  phase_index(p, smh, bid, nblk);
  xcd_barrier(p.bar(), (volatile LAS unsigned*)&xb_words);
  phase_attn(p, smem, bid, nblk);
  xcd_barrier(p.bar(), (volatile LAS unsigned*)&xb_words);
  phase_ymix(p, bid, nblk);
  xcd_barrier(p.bar(), (volatile LAS unsigned*)&xb_words);
  {
    EpiOut e{p};
    phase_gemm(p.ymix(), p.wt_out(), 4, smh, e, bid, nblk);
  }
  xcd_barrier(p.bar(), (volatile LAS unsigned*)&xb_words);
  phase_norm_mod<true>(p.out, p.norm2_w, p.mod(), 3072, 4096, p.h2(), p.h2q(), p.hscale(), bid, nblk);
  xcd_barrier(p.bar(), (volatile LAS unsigned*)&xb_words);
  {
    EpiPs e{p};
    phase_gemm(p.h2(), p.wt_p(), 8, smh, e, bid, nblk);
  }
  xcd_barrier(p.bar(), (volatile LAS unsigned*)&xb_words);
  phase_topk(p, (uint32_t*)smem, bid, nblk);
  xcd_barrier(p.bar(), (volatile LAS unsigned*)&xb_words);
  const SliceSched ss = slice_sched(p.bar(), (volatile LAS unsigned*)&xb_words);
  for (int sl = ss.myord; sl < 8; sl += ss.npop) phase_peer_u(p, (uint32_t*)smem, sl, ss.rank, ss.nloc);
  xcd_barrier(p.bar(), (volatile LAS unsigned*)&xb_words);
  for (int sl = ss.myord; sl < 8; sl += ss.npop) phase_peer_v(p, sl, ss.rank, ss.nloc);
}

extern "C" void kernel_launch(void* const* d_in, const int* in_sizes, int n_in, void* d_out, int out_size, void* d_ws,
                              size_t ws_size, hipStream_t stream) {
  Params p{};
  p.x = (const float*)d_in[0];
  p.c = (const float*)d_in[1];
  p.norm1_w = (const float*)d_in[2];
  p.norm2_w = (const float*)d_in[3];
  p.w_ada = (const float*)d_in[4];
  p.b_ada = (const float*)d_in[5];
  p.w_in = (const float*)d_in[6];
  p.q_norm_w = (const float*)d_in[7];
  p.k_norm_w = (const float*)d_in[8];
  p.conv_w = (const float*)d_in[9];
  p.conv_b = (const float*)d_in[10];
  p.attn_out_norm_w = (const float*)d_in[11];
  p.conv_out_norm_w = (const float*)d_in[12];
  p.w_out = (const float*)d_in[13];
  p.peer_wq = (const float*)d_in[14];
  p.peer_subkeys = (const float*)d_in[15];
  p.peer_u = (const float*)d_in[16];
  p.peer_v = (const float*)d_in[17];
  p.out = (float*)d_out;
  p.ws = (char*)d_ws;
  (void)ws_size;
  (void)in_sizes;
  (void)n_in;
  (void)out_size;

  static int grid_blocks = 0;
  if (!grid_blocks) {
    int dev = 0, cus = 0, per_cu = 0;
    hipGetDevice(&dev);
    hipDeviceGetAttribute(&cus, hipDeviceAttributeMultiprocessorCount, dev);
    hipOccupancyMaxActiveBlocksPerMultiprocessor(&per_cu, fwd_megakernel, NTHR, 0);
    if (per_cu < 1) per_cu = 1;
    grid_blocks = cus * per_cu;
  }
  hipMemsetAsync(p.bar(), 0, XCD_BAR_WORDS * 4, stream);
  void* args[] = {&p};
  hipLaunchCooperativeKernel((void*)fwd_megakernel, dim3(grid_blocks), dim3(NTHR), args, 0, stream);
}
```

```cpp
#include <hip/hip_runtime.h>
#include <hip/hip_fp16.h>
#include <hip/hip_cooperative_groups.h>
#include <stdint.h>

typedef _Float16 half_t;
typedef _Float16 half8 __attribute__((ext_vector_type(8)));
typedef _Float16 half4 __attribute__((ext_vector_type(4)));
typedef _Float16 half2v __attribute__((ext_vector_type(2)));
typedef float f32x2 __attribute__((ext_vector_type(2)));
typedef int i32x4 __attribute__((ext_vector_type(4)));
typedef float f32x4 __attribute__((ext_vector_type(4)));
typedef float f32x16 __attribute__((ext_vector_type(16)));
typedef unsigned int u32x4 __attribute__((ext_vector_type(4)));

#define T_TOK 32768
#define SEQ 8192
#define NBATCH 4
#define DM 1024
#define DIN 3656
#define DINP 3840
#define NEG_INF (-__builtin_huge_valf())
#define NTHR 512
#define LAS __attribute__((address_space(3)))
#define NWAVE 8

struct Params {
  const float *x, *c, *norm1_w, *norm2_w, *w_ada, *b_ada, *w_in, *q_norm_w, *k_norm_w, *conv_w, *conv_b,
      *attn_out_norm_w, *conv_out_norm_w, *w_out, *peer_wq, *peer_subkeys, *peer_u, *peer_v;
  float* out;
  char* ws;
  __host__ __device__ __forceinline__ unsigned* bar() const { return (unsigned*)(ws + 0ull); }
  __host__ __device__ __forceinline__ float* mod() const { return (float*)(ws + 13824ull); }
  __host__ __device__ __forceinline__ half_t* wt_in() const { return (half_t*)(ws + 112128ull); }
  __host__ __device__ __forceinline__ half_t* wt_out() const { return (half_t*)(ws + 7976448ull); }
  __host__ __device__ __forceinline__ half_t* wt_p() const { return (half_t*)(ws + 10073600ull); }
  __host__ __device__ __forceinline__ int8_t* pu8() const { return (int8_t*)(ws + 14267904ull); }
  __host__ __device__ __forceinline__ uint8_t* pv8() const { return (uint8_t*)(ws + 31045120ull); }
  __host__ __device__ __forceinline__ float* uscale() const { return (float*)(ws + 47822336ull); }
  __host__ __device__ __forceinline__ float* hscale() const { return (float*)(ws + 47887872ull); }
  __host__ __device__ __forceinline__ half_t* h() const { return (half_t*)(ws + 48018944ull); }
  __host__ __device__ __forceinline__ half_t* ymix() const { return (half_t*)(ws + 48018944ull); }
  __host__ __device__ __forceinline__ uint16_t* eid() const { return (uint16_t*)(ws + 48018944ull); }
  __host__ __device__ __forceinline__ float* gw() const { return (float*)(ws + 56407552ull); }
  __host__ __device__ __forceinline__ half_t* gwh() const { return (half_t*)gw(); }
  __host__ __device__ __forceinline__ half_t* coefh() const { return (half_t*)coef(); }
  __host__ __device__ __forceinline__ float* coef() const { return (float*)(ws + 73184768ull); }
  __host__ __device__ __forceinline__ half_t* q() const { return (half_t*)(ws + 115127808ull); }
  __host__ __device__ __forceinline__ half_t* k() const { return (half_t*)(ws + 148682240ull); }
  __host__ __device__ __forceinline__ half_t* v() const { return (half_t*)(ws + 182236672ull); }
  __host__ __device__ __forceinline__ half_t* vt() const { return (half_t*)(ws + 215791104ull); }
  __host__ __device__ __forceinline__ half_t* ps() const { return (half_t*)(ws + 115127808ull); }
  __host__ __device__ __forceinline__ half_t* cb() const { return (half_t*)(ws + 249345536ull); }
  __host__ __device__ __forceinline__ half_t* uu() const { return (half_t*)(ws + 282899968ull); }
  __host__ __device__ __forceinline__ half_t* h2() const { return (half_t*)(ws + 249345536ull); }
  __host__ __device__ __forceinline__ half_t* x1h() const { return (half_t*)(ws + 249345536ull); }
  __host__ __device__ __forceinline__ half_t* iq() const { return (half_t*)(ws + 316454400ull); }
  __host__ __device__ __forceinline__ half_t* ik() const { return (half_t*)(ws + 350008832ull); }
  __host__ __device__ __forceinline__ float* iw() const { return (float*)(ws + 354203136ull); }
  __host__ __device__ __forceinline__ uint8_t* maskb() const { return (uint8_t*)(ws + 355251712ull); }
  __host__ __device__ __forceinline__ half_t* yattn() const { return (half_t*)(ws + 493663744ull); }
  __host__ __device__ __forceinline__ int8_t* h2q() const { return (int8_t*)(ws + 493663744ull); }
  __host__ __device__ __forceinline__ int8_t* h8() const { return (int8_t*)(ws + 182236672ull); }
  __host__ __device__ __forceinline__ float* hs1() const { return (float*)(ws + 527218176ull); }
  __host__ __device__ __forceinline__ int8_t* wt8() const { return (int8_t*)(ws + 527349248ull); }
  __host__ __device__ __forceinline__ float* cs8() const { return (float*)(ws + 528922112ull); }
  __host__ __device__ __forceinline__ int8_t* wtp8() const { return (int8_t*)(ws + 528926208ull); }
  __host__ __device__ __forceinline__ float* csp() const { return (float*)(ws + 531023360ull); }
  __host__ __device__ __forceinline__ int8_t* wtin8() const { return (int8_t*)(ws + 531031552ull); }
  __host__ __device__ __forceinline__ float* csin() const { return (float*)(ws + 534963712ull); }
};

__device__ __forceinline__ int opq_tid() {
  int t = threadIdx.x;
  asm volatile("" : "+v"(t));
  return t;
}
#define TIDX opq_tid()

__device__ __forceinline__ int wave_sum_dpp(int v) {
  v += __builtin_amdgcn_update_dpp(0, v, 0x111, 0xF, 0xF, true);
  v += __builtin_amdgcn_update_dpp(0, v, 0x112, 0xF, 0xF, true);
  v += __builtin_amdgcn_update_dpp(0, v, 0x114, 0xF, 0xF, true);
  v += __builtin_amdgcn_update_dpp(0, v, 0x118, 0xF, 0xF, true);
  v += __builtin_amdgcn_update_dpp(0, v, 0x142, 0xA, 0xF, true);
  v += __builtin_amdgcn_update_dpp(0, v, 0x143, 0xC, 0xF, true);
  return __builtin_amdgcn_readlane(v, 63);
}
__device__ __forceinline__ int wave_max_dpp(int v) {
  v = max(v, __builtin_amdgcn_update_dpp(0, v, 0x111, 0xF, 0xF, true));
  v = max(v, __builtin_amdgcn_update_dpp(0, v, 0x112, 0xF, 0xF, true));
  v = max(v, __builtin_amdgcn_update_dpp(0, v, 0x114, 0xF, 0xF, true));
  v = max(v, __builtin_amdgcn_update_dpp(0, v, 0x118, 0xF, 0xF, true));
  v = max(v, __builtin_amdgcn_update_dpp(0, v, 0x142, 0xA, 0xF, true));
  v = max(v, __builtin_amdgcn_update_dpp(0, v, 0x143, 0xC, 0xF, true));
  return __builtin_amdgcn_readlane(v, 63);
}
#define DPPF(x, ctrl, rowmask) __int_as_float(__builtin_amdgcn_update_dpp(0, __float_as_int(x), (ctrl), (rowmask), 0xF, true))
__device__ __forceinline__ float wave_sum(float v) {
  v += DPPF(v, 0x111, 0xF);
  v += DPPF(v, 0x112, 0xF);
  v += DPPF(v, 0x114, 0xF);
  v += DPPF(v, 0x118, 0xF);
  v += DPPF(v, 0x142, 0xA);
  v += DPPF(v, 0x143, 0xC);
  return __int_as_float(__builtin_amdgcn_readlane(__float_as_int(v), 63));
}
__device__ __forceinline__ int wave_sum_i(int v) { return wave_sum_dpp(v); }
__device__ __forceinline__ float wave_max(float v) {
  v = fmaxf(v, DPPF(v, 0x111, 0xF));
  v = fmaxf(v, DPPF(v, 0x112, 0xF));
  v = fmaxf(v, DPPF(v, 0x114, 0xF));
  v = fmaxf(v, DPPF(v, 0x118, 0xF));
  v = fmaxf(v, DPPF(v, 0x142, 0xA));
  v = fmaxf(v, DPPF(v, 0x143, 0xC));
  return __int_as_float(__builtin_amdgcn_readlane(__float_as_int(v), 63));
}

__device__ __forceinline__ void prep_ada(const Params& p, float* sm, int bid, int nblk) {
  float* s_silu = sm;
  float* red = sm + 4096;
  const int tid = TIDX;
  for (int i = tid; i < 4096; i += NTHR) {
    float cv = p.c[i];
    s_silu[i] = cv / (1.f + __expf(-cv));
  }
  __syncthreads();
  for (int tile = bid; tile < 192; tile += nblk) {
    const int col = tid & 31, ks = tid >> 5;
    const int j = tile * 32 + col;
    float a0 = 0, a1 = 0, a2 = 0, a3 = 0;
    const float* wp = p.w_ada + (size_t)(ks * 64) * 6144 + j;
    float wreg[64];
#pragma unroll
    for (int kk = 0; kk < 64; ++kk) wreg[kk] = wp[(size_t)kk * 6144];
#pragma unroll
    for (int kk = 0; kk < 64; ++kk) {
      const float w = wreg[kk];
      const int k = ks * 64 + kk;
      a0 += s_silu[k] * w;
      a1 += s_silu[1024 + k] * w;
      a2 += s_silu[2048 + k] * w;
      a3 += s_silu[3072 + k] * w;
    }
    red[(ks * 4 + 0) * 32 + col] = a0;
    red[(ks * 4 + 1) * 32 + col] = a1;
    red[(ks * 4 + 2) * 32 + col] = a2;
    red[(ks * 4 + 3) * 32 + col] = a3;
    __syncthreads();
    if (tid < 128) {
      const int b = tid >> 5, jj = tid & 31;
      float sum = 0.f;
#pragma unroll
      for (int q = 0; q < 16; ++q) sum += red[(q * 4 + b) * 32 + jj];
      p.mod()[b * 6144 + tile * 32 + jj] = sum + p.b_ada[tile * 32 + jj];
    }
    __syncthreads();
  }
}

__device__ __forceinline__ int perm_in_col(int n) {
  if (n >= DIN) return -1;
  if (n >= 2048 && n < 3072) {
    int g = (n - 2048) >> 6, jj = (n - 2048) & 63;
    return (jj < 32) ? (2048 + g * 32 + jj) : (2560 + g * 32 + (jj - 32));
  }
  return n;
}

template <bool PERM>
__device__ __forceinline__ void prep_transpose(const float* __restrict__ src, half_t* __restrict__ dst, int N, int Npad, float* sm,
                               int bid, int nblk) {
  const int tid = TIDX;
  const int ntn = Npad / 64;
  float nv[8];
#define PT_LOAD(TILE)                                                      \
  {                                                                        \
    const int nt_ = (TILE) / 16, kt_ = (TILE) % 16;                        \
    _Pragma("unroll") for (int i = 0; i < 8; ++i) {                        \
      const int kk = i * 8 + (tid >> 6), n = nt_ * 64 + (tid & 63);        \
      float v = 0.f;                                                       \
      if (PERM || n < N) {                                                 \
        const int col = PERM ? perm_in_col(n) : n;                         \
        if (col >= 0) v = src[(size_t)(kt_ * 64 + kk) * N + col];          \
      }                                                                    \
      nv[i] = v;                                                           \
    }                                                                      \
  }
  if (bid < ntn * 16) PT_LOAD(bid)
  for (int tile = bid; tile < ntn * 16; tile += nblk) {
    const int nt = tile / 16, kt = tile % 16;
    const int n0 = nt * 64, k0 = kt * 64;
    float cv[8];
#pragma unroll
    for (int i = 0; i < 8; ++i) cv[i] = nv[i];
    if (tile + nblk < ntn * 16) PT_LOAD(tile + nblk)
#pragma unroll
    for (int i = 0; i < 8; ++i) {
      int kk = i * 8 + (tid >> 6), nn = tid & 63;
      sm[kk * 65 + nn] = cv[i];
    }
    __syncthreads();
#pragma unroll
    for (int i = 0; i < 8; ++i) {
      int nn = i * 8 + (tid >> 6), kk = tid & 63;
      dst[(size_t)(n0 + nn) * 1024 + k0 + kk] = (half_t)sm[kk * 65 + nn];
    }
    __syncthreads();
  }
#undef PT_LOAD
}

__device__ __forceinline__ void prep_wprime(const Params& p, float* sm, int bid, int nblk) {
  float* sA = sm;
  float* sB = sm + 64 * 132;
  const int tid = TIDX;
  for (int tile = bid; tile < 512; tile += nblk) {
    const int hp = tile >> 5, nt = (tile >> 4) & 1, kt = tile & 15;
    const int n0 = nt * 64, k0 = kt * 64;
#pragma unroll
    for (int i = tid; i < 64 * 128; i += NTHR) {
      int r = i >> 7, d = i & 127;
      sA[r * 132 + d] = p.peer_subkeys[((size_t)(hp * 128 + n0 + r)) * 128 + d];
      sB[r * 132 + d] = p.peer_wq[(size_t)(k0 + r) * 2048 + hp * 128 + d];
    }
    __syncthreads();
    const int tn = tid >> 4, tk = tid & 15;
    float acc[2][4];
#pragma unroll
    for (int a = 0; a < 2; ++a)
#pragma unroll
      for (int b = 0; b < 4; ++b) acc[a][b] = 0.f;
    for (int d = 0; d < 128; d += 4) {
      f32x4 av[2], bv[4];
#pragma unroll
      for (int a = 0; a < 2; ++a) av[a] = *(const f32x4*)(sA + (tn * 2 + a) * 132 + d);
#pragma unroll
      for (int b = 0; b < 4; ++b) bv[b] = *(const f32x4*)(sB + (tk * 4 + b) * 132 + d);
#pragma unroll
      for (int i = 0; i < 4; ++i)
#pragma unroll
        for (int a = 0; a < 2; ++a)
#pragma unroll
          for (int b = 0; b < 4; ++b) acc[a][b] += av[a][i] * bv[b][i];
    }
#pragma unroll
    for (int a = 0; a < 2; ++a)
#pragma unroll
      for (int b = 0; b < 4; ++b)
        p.wt_p()[(size_t)(hp * 128 + n0 + tn * 2 + a) * 1024 + k0 + tk * 4 + b] = (half_t)acc[a][b];
    __syncthreads();
  }
}

__device__ __forceinline__ void quant_rows(const Params& p, int bid, int nblk) {
  const int lane = TIDX & 63, wave = TIDX >> 6;
  const int RT = DINP + 1024 + 2048, rstep = nblk * NWAVE;
  for (int r0 = bid * NWAVE + wave; r0 < RT; r0 += 4 * rstep) {
    half8 a[4], b[4];
    int8_t* dst[4];
    float* sc[4];
#pragma unroll
    for (int i = 0; i < 4; ++i) {
      const int r = min(r0 + i * rstep, RT - 1);
      const half_t* src;
      if (r < DINP) {
        src = p.wt_in() + (size_t)r * 1024;
        dst[i] = p.wtin8() + (size_t)r * 1024;
        sc[i] = p.csin() + r;
      } else if (r < DINP + 1024) {
        src = p.wt_out() + (size_t)(r - DINP) * 1024;
        dst[i] = p.wt8() + (size_t)(r - DINP) * 1024;
        sc[i] = p.cs8() + (r - DINP);
      } else {
        src = p.wt_p() + (size_t)(r - DINP - 1024) * 1024;
        dst[i] = p.wtp8() + (size_t)(r - DINP - 1024) * 1024;
        sc[i] = p.csp() + (r - DINP - 1024);
      }
      a[i] = *(const half8*)(src + lane * 16);
      b[i] = *(const half8*)(src + lane * 16 + 8);
    }
#pragma unroll
    for (int i = 0; i < 4; ++i) {
      float f[16];
      float am = 0.f;
#pragma unroll
      for (int j = 0; j < 8; ++j) {
        f[j] = (float)a[i][j];
        f[8 + j] = (float)b[i][j];
      }
#pragma unroll
      for (int j = 0; j < 16; ++j) am = fmaxf(am, fabsf(f[j]));
      am = fmaxf(wave_max(am), 1e-20f);
      const float inv = 127.f / am;
      u32x4 o;
#pragma unroll
      for (int d = 0; d < 4; ++d) {
        uint32_t w = 0u;
#pragma unroll
        for (int j = 0; j < 4; ++j) w |= (uint32_t)((int)rintf(f[4 * d + j] * inv) & 255) << (8 * j);
        o[d] = w;
      }
      if (r0 + i * rstep < RT) {
        *(u32x4*)(dst[i] + lane * 16) = o;
        if (lane == 0) *sc[i] = am * (1.f / 127.f);
      }
    }
  }
}

__device__ __forceinline__ void prep_tables(const Params& p, int bid, int nblk, int part) {
  const int lane = TIDX & 63, wave = TIDX >> 6;
  const int e0 = bid * NWAVE + wave + part * nblk * NWAVE, estep = 2 * nblk * NWAVE;
  float4 un[4], vn[4];
  if (e0 < 16384) {
    const float4* ur = (const float4*)(p.peer_u + (size_t)e0 * 1024 + lane * 16);
    const float4* vr = (const float4*)(p.peer_v + (size_t)e0 * 1024 + lane * 16);
#pragma unroll
    for (int c = 0; c < 4; ++c) {
      un[c] = ur[c];
      vn[c] = vr[c];
    }
  }
  for (int e = e0; e < 16384; e += estep) {
    float4 u[4], v[4];
#pragma unroll
    for (int c = 0; c < 4; ++c) {
      u[c] = un[c];
      v[c] = vn[c];
    }
    {
      const int en = (e + estep < 16384) ? e + estep : e;
      const float4* ur = (const float4*)(p.peer_u + (size_t)en * 1024 + lane * 16);
      const float4* vr = (const float4*)(p.peer_v + (size_t)en * 1024 + lane * 16);
#pragma unroll
      for (int c = 0; c < 4; ++c) {
        un[c] = ur[c];
        vn[c] = vr[c];
      }
    }
    float am = 0.f;
#pragma unroll
    for (int c = 0; c < 4; ++c)
      am = fmaxf(am, fmaxf(fmaxf(fabsf(u[c].x), fabsf(u[c].y)), fmaxf(fabsf(u[c].z), fabsf(u[c].w))));
    am = wave_max(am);
    am = fmaxf(am, 1e-20f);
    const float inv = 127.f / am;
    u32x4 qu, qv;
#pragma unroll
    for (int c = 0; c < 4; ++c) {
      int q0 = (int)rintf(u[c].x * inv), q1 = (int)rintf(u[c].y * inv), q2 = (int)rintf(u[c].z * inv),
          q3 = (int)rintf(u[c].w * inv);
      qu[c] = (uint32_t)(q0 & 255) | ((uint32_t)(q1 & 255) << 8) | ((uint32_t)(q2 & 255) << 16) |
              ((uint32_t)(q3 & 255) << 24);
      float f0 = fminf(fmaxf(v[c].x * 128.f, -448.f), 448.f), f1 = fminf(fmaxf(v[c].y * 128.f, -448.f), 448.f);
      float f2 = fminf(fmaxf(v[c].z * 128.f, -448.f), 448.f), f3 = fminf(fmaxf(v[c].w * 128.f, -448.f), 448.f);
      int pk = __builtin_amdgcn_cvt_pk_fp8_f32(f0, f1, 0, false);
      pk = __builtin_amdgcn_cvt_pk_fp8_f32(f2, f3, pk, true);
      qv[c] = (uint32_t)pk;
    }
    const int r = (e & 7) * 2048 + (e >> 3);
    *(u32x4*)(p.pu8() + (size_t)r * 1024 + lane * 16) = qu;
    *(u32x4*)(p.pv8() + ((size_t)(lane >> 3) * 16384 + e) * 128 + (lane & 7) * 16) = qv;
    if (lane == 0) p.uscale()[e] = am * (1.f / 127.f);
  }
}

template <bool QUANT, bool XH>
__device__ __forceinline__ void phase_norm_mod(const void* __restrict__ xin_, const float* __restrict__ nw,
                                               const float* __restrict__ mod, int shift_off, int scale_off,
                                               half_t* __restrict__ hout, int8_t* __restrict__ qout,
                                               float* __restrict__ qscale, int bid, int nblk) {
  const int lane = TIDX & 63, wave = TIDX >> 6;
  const int tok0 = bid * NWAVE + wave, tstep = nblk * NWAVE;
  half4 hn[4];
  float4 fn[4];
  if (tok0 < T_TOK) {
    if (XH) {
      const half4* xr = (const half4*)((const half_t*)xin_ + (size_t)tok0 * 1024);
#pragma unroll
      for (int c = 0; c < 4; ++c) hn[c] = xr[c * 64 + lane];
    } else {
      const float4* xr = (const float4*)((const float*)xin_ + (size_t)tok0 * 1024);
#pragma unroll
      for (int c = 0; c < 4; ++c) fn[c] = xr[c * 64 + lane];
    }
  }
  float4 gsc[4], gsh[4];
  int bcur = -1;
  for (int tok = tok0; tok < T_TOK; tok += tstep) {
    const int b = tok >> 13;
    float4 v[4];
    float ss = 0.f;
    if (XH) {
#pragma unroll
      for (int c = 0; c < 4; ++c) v[c] = make_float4((float)hn[c][0], (float)hn[c][1], (float)hn[c][2], (float)hn[c][3]);
    } else {
#pragma unroll
      for (int c = 0; c < 4; ++c) v[c] = fn[c];
    }
    {
      const int tn = (tok + tstep < T_TOK) ? tok + tstep : tok;
      if (XH) {
        const half4* xr = (const half4*)((const half_t*)xin_ + (size_t)tn * 1024);
#pragma unroll
        for (int c = 0; c < 4; ++c) hn[c] = xr[c * 64 + lane];
      } else {
        const float4* xr = (const float4*)((const float*)xin_ + (size_t)tn * 1024);
#pragma unroll
        for (int c = 0; c < 4; ++c) fn[c] = xr[c * 64 + lane];
      }
    }
    if (b != bcur) {
      bcur = b;
#pragma unroll
      for (int c = 0; c < 4; ++c) {
        const int e = c * 256 + lane * 4;
        const float4 w = *(const float4*)(nw + e);
        const float4 sc = *(const float4*)(mod + b * 6144 + scale_off + e);
        gsh[c] = *(const float4*)(mod + b * 6144 + shift_off + e);
        gsc[c] = make_float4(w.x * (1.f + sc.x), w.y * (1.f + sc.y), w.z * (1.f + sc.z), w.w * (1.f + sc.w));
      }
    }
#pragma unroll
    for (int c = 0; c < 4; ++c) ss += v[c].x * v[c].x + v[c].y * v[c].y + v[c].z * v[c].z + v[c].w * v[c].w;
    ss = wave_sum(ss);
    const float rs = rsqrtf(ss * (1.f / 1024.f) + 1e-6f);
    float am = 0.f;
#pragma unroll
    for (int c = 0; c < 4; ++c) {
      const int e = c * 256 + lane * 4;
      v[c].x = v[c].x * rs * gsc[c].x + gsh[c].x;
      v[c].y = v[c].y * rs * gsc[c].y + gsh[c].y;
      v[c].z = v[c].z * rs * gsc[c].z + gsh[c].z;
      v[c].w = v[c].w * rs * gsc[c].w + gsh[c].w;
      if (!QUANT) {
        half4 o;
        o[0] = (half_t)v[c].x;
        o[1] = (half_t)v[c].y;
        o[2] = (half_t)v[c].z;
        o[3] = (half_t)v[c].w;
        *(half4*)(hout + (size_t)tok * 1024 + e) = o;
      }
      if (QUANT) am = fmaxf(am, fmaxf(fmaxf(fabsf(v[c].x), fabsf(v[c].y)), fmaxf(fabsf(v[c].z), fabsf(v[c].w))));
    }
    if (QUANT) {
      am = fmaxf(wave_max(am), 1e-20f);
      const float inv = 127.f / am;
#pragma unroll
      for (int c = 0; c < 4; ++c) {
        int q0 = (int)rintf(v[c].x * inv), q1 = (int)rintf(v[c].y * inv), q2 = (int)rintf(v[c].z * inv),
            q3 = (int)rintf(v[c].w * inv);
        uint32_t pk = (uint32_t)(q0 & 255) | ((uint32_t)(q1 & 255) << 8) | ((uint32_t)(q2 & 255) << 16) |
                      ((uint32_t)(q3 & 255) << 24);
        *(uint32_t*)(qout + (size_t)tok * 1024 + c * 256 + lane * 4) = pk;
      }
      if (lane == 0) qscale[tok] = am * (1.f / 127.f);
    }
  }
}

#define G8_BK 64
#define G8_HT (128 * 64)
__device__ __forceinline__ int g8_lds_byte(int r, int c) {
  int st = (r >> 4) * 2 + (c >> 5), rr = r & 15, cc = c & 31, ob = rr * 64 + cc * 2;
  return st * 1024 + (ob ^ (((ob >> 9) & 1) << 5));
}
__device__ __forceinline__ void g8_stage_rc(int b, int& R, int& C) {
  int st = b / 1024, sb = b % 1024, swz = sb ^ (((sb >> 9) & 1) << 5);
  R = (st >> 1) * 16 + swz / 64;
  C = (st & 1) * 32 + (swz % 64) / 2;
}
typedef f32x4 g8acc_t[2][2][4][2];

template <class Epi, bool I8>
__device__ __forceinline__ void gemm8_tile(const half_t* __restrict__ A, const half_t* __restrict__ Bt, const int K,
                                           const int brow, const int bcol, half_t* shm, const Epi& epi) {
#define G8_SA(b, h) (shm + ((b) * 2 + (h)) * G8_HT)
#define G8_SB(b, h) (shm + (4 + (b) * 2 + (h)) * G8_HT)
#define G8_STAGE(P, BASE, br, kt)                                                                          \
  do {                                                                                                     \
    const char* _gb = (const char*)(BASE) + ((long)(br) * K + (long)(kt) * G8_BK) * 2;                     \
    __builtin_amdgcn_global_load_lds((const unsigned*)(_gb + voff0), (LAS unsigned*)((char*)(P) + TIDX * 16), 16, 0, 0);        \
    __builtin_amdgcn_global_load_lds((const unsigned*)(_gb + voff1), (LAS unsigned*)((char*)(P) + TIDX * 16 + 8192), 16, 0, 0); \
  } while (0)
#define G8_LDA(dst, b, h)                                                                                  \
  for (int m = 0; m < 4; ++m)                                                                              \
    for (int k = 0; k < 2; ++k)                                                                            \
  dst[m][k] = *reinterpret_cast<const half8*>(baseA + (((b) * 2 + (h)) * 16384 + m * 2048 + k * 1024))
#define G8_LDB(dst, b, h)                                                                                  \
  for (int n = 0; n < 2; ++n)                                                                              \
    for (int k = 0; k < 2; ++k)                                                                            \
  dst[n][k] = *reinterpret_cast<const half8*>(baseB + (((b) * 2 + (h)) * 16384 + n * 2048 + k * 1024))
#define G8_MMA(ai, bj, At, Bx)                                                                             \
  do {                                                                                                     \
    __builtin_amdgcn_s_setprio(1);                                                                         \
    for (int m = 0; m < 4; ++m)                                                                            \
      for (int n = 0; n < 2; ++n)                                                                          \
        for (int k = 0; k < 2; ++k)                                                                        \
          if (I8)                                                                                          \
            acc[ai][bj][m][n] = __builtin_bit_cast(f32x4, __builtin_amdgcn_mfma_i32_16x16x64_i8(            \
                __builtin_bit_cast(i32x4, Bx[n][k]), __builtin_bit_cast(i32x4, At[m][k]),                   \
                __builtin_bit_cast(i32x4, acc[ai][bj][m][n]), 0, 0, 0));                                    \
          else                                                                                             \
            acc[ai][bj][m][n] =                                                                            \
                __builtin_amdgcn_mfma_f32_16x16x32_f16(Bx[n][k], At[m][k], acc[ai][bj][m][n], 0, 0, 0);    \
    __builtin_amdgcn_s_setprio(0);                                                                         \
  } while (0)
#define G8_WAIT_V(n) asm volatile("s_waitcnt vmcnt(" #n ")" ::: "memory")
#define G8_WAIT_L(n) asm volatile("s_waitcnt lgkmcnt(" #n ")" ::: "memory")
#define G8_BAR __builtin_amdgcn_s_barrier()
#define G8_SCHED __builtin_amdgcn_sched_barrier(0)
  const int wid = TIDX >> 6, lane = TIDX & 63, wr = wid >> 2, wc = wid & 3, fr = lane & 15, fq = lane >> 4;
  const char* baseA;
  const char* baseB;
  {
    unsigned lb = (unsigned)g8_lds_byte(fr, fq * 8);
    unsigned oa = lb + wr * 8192, ob = lb + wc * 4096 + 65536;
    asm volatile("" : "+v"(oa));
    asm volatile("" : "+v"(ob));
    baseA = (const char*)shm + oa;
    baseB = (const char*)shm + ob;
  }
  unsigned voff0, voff1;
  {
    int r0, c0, r1, c1;
    g8_stage_rc(TIDX * 16, r0, c0);
    g8_stage_rc(TIDX * 16 + 8192, r1, c1);
    voff0 = (unsigned)(r0 * K + c0) * 2u;
    voff1 = (unsigned)(r1 * K + c1) * 2u;
    asm volatile("" : "+v"(voff0));
    asm volatile("" : "+v"(voff1));
  }
  g8acc_t acc;
#pragma unroll
  for (int a = 0; a < 2; ++a)
#pragma unroll
    for (int b = 0; b < 2; ++b)
#pragma unroll
      for (int m = 0; m < 4; ++m)
#pragma unroll
        for (int n = 0; n < 2; ++n) acc[a][b][m][n] = (f32x4){0.f, 0.f, 0.f, 0.f};
  half8 At[4][2], B0[2][2], B1[2][2];
  const int nt = K / G8_BK;
  asm volatile("s_waitcnt vmcnt(0)" ::: "memory");
  G8_STAGE(G8_SB(0, 0), Bt, bcol, 0);
  G8_STAGE(G8_SA(0, 0), A, brow, 0);
  G8_STAGE(G8_SB(0, 1), Bt, bcol + 128, 0);
  G8_STAGE(G8_SA(0, 1), A, brow + 128, 0);
  G8_STAGE(G8_SB(1, 0), Bt, bcol, 1);
  G8_STAGE(G8_SA(1, 0), A, brow, 1);
  G8_STAGE(G8_SB(1, 1), Bt, bcol + 128, 1);
  if (wr == 1) G8_BAR;
  G8_WAIT_V(10);
  G8_BAR;
  G8_WAIT_V(6);
  G8_BAR;
#pragma unroll 1
  for (int t = 0; t < nt - 2; t += 2) {
    G8_LDB(B0, 0, 0); G8_SCHED; G8_LDA(At, 0, 0); G8_STAGE(G8_SA(1, 1), A, brow + 128, t + 1);
    G8_WAIT_L(8); G8_BAR; G8_WAIT_L(0); G8_MMA(0, 0, At, B0); G8_BAR; G8_SCHED;
    G8_LDB(B1, 0, 1); G8_STAGE(G8_SB(0, 0), Bt, bcol, t + 2);
    G8_BAR; G8_WAIT_L(0); G8_MMA(0, 1, At, B1); G8_BAR;
    G8_LDA(At, 0, 1); G8_STAGE(G8_SA(0, 0), A, brow, t + 2);
    G8_BAR; G8_WAIT_L(0); G8_MMA(1, 0, At, B0); G8_BAR; G8_SCHED;
    G8_STAGE(G8_SB(0, 1), Bt, bcol + 128, t + 2);
    G8_WAIT_V(6); G8_BAR; G8_MMA(1, 1, At, B1); G8_BAR;
    G8_LDB(B0, 1, 0); G8_SCHED; G8_LDA(At, 1, 0); G8_STAGE(G8_SA(0, 1), A, brow + 128, t + 2);
    G8_WAIT_L(8); G8_BAR; G8_WAIT_L(0); G8_MMA(0, 0, At, B0); G8_BAR; G8_SCHED;
    G8_LDB(B1, 1, 1); G8_STAGE(G8_SB(1, 0), Bt, bcol, t + 3);
    G8_BAR; G8_WAIT_L(0); G8_MMA(0, 1, At, B1); G8_BAR;
    G8_LDA(At, 1, 1); G8_STAGE(G8_SA(1, 0), A, brow, t + 3);
    G8_BAR; G8_WAIT_L(0); G8_MMA(1, 0, At, B0); G8_BAR; G8_SCHED;
    G8_STAGE(G8_SB(1, 1), Bt, bcol + 128, t + 3);
    G8_WAIT_V(6); G8_BAR; G8_MMA(1, 1, At, B1); G8_BAR;
  }
  {
    G8_LDB(B0, 0, 0); G8_LDA(At, 0, 0); G8_STAGE(G8_SA(1, 1), A, brow + 128, nt - 1);
    G8_BAR; G8_WAIT_L(0); G8_MMA(0, 0, At, B0); G8_BAR;
    G8_LDB(B1, 0, 1); G8_BAR; G8_WAIT_L(0); G8_MMA(0, 1, At, B1); G8_BAR;
    G8_LDA(At, 0, 1); G8_WAIT_V(4); G8_BAR; G8_WAIT_L(0); G8_MMA(1, 0, At, B0); G8_MMA(1, 1, At, B1); G8_BAR;
  }
  {
    G8_LDB(B0, 1, 0); G8_LDA(At, 1, 0); G8_WAIT_V(2); G8_BAR; G8_WAIT_L(0); G8_MMA(0, 0, At, B0); G8_BAR;
    G8_LDB(B1, 1, 1); G8_WAIT_V(0); G8_BAR; G8_WAIT_L(0); G8_MMA(0, 1, At, B1); G8_BAR;
    G8_LDA(At, 1, 1); G8_BAR; G8_WAIT_L(0); G8_MMA(1, 0, At, B0); G8_MMA(1, 1, At, B1); G8_BAR;
  }
  if (wr == 0) G8_BAR;
  {
    const unsigned s0 = (unsigned)(((wc & 1) * 8 + fq) ^ fr);
    unsigned w0 = (unsigned)((wr * 64 + fr) * 1024 + (wc >> 1) * 256) + s0 * 16u;
    asm volatile("" : "+v"(w0));
    char* wb0 = (char*)shm + w0;
    char* wb1 = (char*)shm + (w0 ^ 64u);
#pragma unroll
    for (int ai = 0; ai < 2; ++ai) {
#pragma unroll
      for (int bj = 0; bj < 2; ++bj)
#pragma unroll
        for (int m = 0; m < 4; ++m) {
          const i32x4 i0 = __builtin_bit_cast(i32x4, acc[ai][bj][m][0]), i1 = __builtin_bit_cast(i32x4, acc[ai][bj][m][1]);
          *(f32x4*)(wb0 + (bj * 512 + m * 16384)) = I8 ? __builtin_convertvector(i0, f32x4) : acc[ai][bj][m][0];
          *(f32x4*)(wb1 + (bj * 512 + m * 16384)) = I8 ? __builtin_convertvector(i1, f32x4) : acc[ai][bj][m][1];
        }
      __syncthreads();
      const float* ct = (const float*)shm;
      if (Epi::kVT && bcol >= 1024 && bcol < 1536) {
        const int wv_ = TIDX >> 6, q4 = lane & 31, ch = lane >> 5;
        const int r0 = 4 * q4;
        const float* rp = ct + r0 * 256;
        const int sw = 4 * (q4 & 3);
        const int mq = q4 & 15;
        const int poff = 32 * (mq & 1) + 16 * (mq >> 3) + 4 * ((mq >> 1) & 3);
        uint8_t* vtp = (uint8_t*)epi.p.vt() + ((size_t)((brow >> 13) * 512 + (bcol - 1024) + wv_ * 32 + ch * 16)) * 8192 +
                       (brow & 8191) + ai * 128 + (q4 >> 4) * 64 + poff;
        f32x4 sa4 = {1.f, 1.f, 1.f, 1.f}, sbv[4];
        if (I8) {
          sa4 = *(const f32x4*)(epi.rsc() + brow + ai * 128 + r0);
#pragma unroll
          for (int cg = 0; cg < 4; ++cg) sbv[cg] = *(const f32x4*)(epi.csc() + bcol + wv_ * 32 + ch * 16 + cg * 4);
        }
#pragma unroll
        for (int cg = 0; cg < 4; ++cg) {
          const int cs = wv_ * 8 + ch * 4 + cg;
          f32x4 v0 = *(const f32x4*)(rp + ((cs ^ sw) << 2)), v1 = *(const f32x4*)(rp + 256 + ((cs ^ (sw + 1)) << 2));
          f32x4 v2 = *(const f32x4*)(rp + 512 + ((cs ^ (sw + 2)) << 2)), v3 = *(const f32x4*)(rp + 768 + ((cs ^ (sw + 3)) << 2));
          if (I8) {
            v0 *= sbv[cg] * sa4[0];
            v1 *= sbv[cg] * sa4[1];
            v2 *= sbv[cg] * sa4[2];
            v3 *= sbv[cg] * sa4[3];
          }
#pragma unroll
          for (int i = 0; i < 4; ++i) {
            int pk = __builtin_amdgcn_cvt_pk_fp8_f32(fminf(fmaxf(v0[i], -448.f), 448.f), fminf(fmaxf(v1[i], -448.f), 448.f), 0, false);
            pk = __builtin_amdgcn_cvt_pk_fp8_f32(fminf(fmaxf(v2[i], -448.f), 448.f), fminf(fmaxf(v3[i], -448.f), 448.f), pk, true);
            *(uint32_t*)(vtp + (size_t)(cg * 4 + i) * 8192) = (uint32_t)pk;
          }
        }
      } else {
        const int c4 = TIDX & 63, rw = TIDX >> 6;
        f32x4 csv = {1.f, 1.f, 1.f, 1.f};
        float rs0 = 1.f, rs1 = 1.f, rs2 = 1.f;
        const float* rsp = epi.rsc() + brow + ai * 128 + rw;
        if (I8) {
          csv = *(const f32x4*)(epi.csc() + bcol + c4 * 4);
          rs0 = rsp[0];
          rs1 = rsp[8];
          rs2 = rsp[16];
        }
        const int grow = brow + ai * 128 + rw, gcol = bcol + c4 * 4;
        const typename Epi::Col ecol = epi.colctx(brow, gcol);
        typename Epi::Pre pr0 = epi.prefetch(grow, gcol), pr1 = epi.prefetch(grow + 8, gcol), pr2 = epi.prefetch(grow + 16, gcol);
#pragma unroll
        for (int it = 0; it < 16; ++it) {
          const int row = it * 8 + rw;
          f32x4 v = *(const f32x4*)(ct + row * 256 + ((c4 ^ (row & 15)) << 2));
          const typename Epi::Pre prc = pr0;
          pr0 = pr1;
          pr1 = pr2;
          pr2 = epi.prefetch(grow + min(it + 3, 15) * 8, gcol);
          if (I8) {
            v *= csv * rs0;
            rs0 = rs1;
            rs1 = rs2;
            rs2 = rsp[min(it + 3, 15) * 8];
          }
          epi(v, brow + ai * 128 + row, gcol, lane, ecol, prc);
        }
      }
      __syncthreads();
    }
  }
}

__device__ __forceinline__ void topk_item(const Params& p, uint32_t* mytab, const half_t* row, const int tok, const int hp,
                                          const int lane);

struct EpiIn {
  Params p;
  static constexpr bool kVT = true;
  static constexpr bool kTopk = false;
  __host__ __device__ __forceinline__ void after_tile(int, int, uint32_t*) const {}
  __host__ __device__ __forceinline__ const int8_t* a8() const { return p.h8(); }
  __host__ __device__ __forceinline__ const int8_t* b8() const { return p.wtin8(); }
  __host__ __device__ __forceinline__ const float* rsc() const { return p.hs1(); }
  __host__ __device__ __forceinline__ const float* csc() const { return p.csin(); }
  struct Col {
    f32x4 w;
  };
  struct Pre {};
  __host__ __device__ __forceinline__ Col colctx(int brow, int col) const {
    Col c;
    c.w = (f32x4){1.f, 1.f, 1.f, 1.f};
    if (col < 1024) c.w = *(const f32x4*)((col < 512 ? p.q_norm_w : p.k_norm_w) + (col & 63));
    return c;
  }
  __host__ __device__ __forceinline__ Pre prefetch(int, int) const { return Pre{}; }
  __host__ __device__ __forceinline__ void operator()(const f32x4& v, int row, int col, int lane, const Col& ec, const Pre&) const {
    const int cb = col & ~63, cin = col & 63;
    if (cb < 1024) {
      float ss = v[0] * v[0] + v[1] * v[1] + v[2] * v[2] + v[3] * v[3];
      ss += DPPF(ss, 0xB1, 0xF);
      ss += DPPF(ss, 0x4E, 0xF);
      ss += DPPF(ss, 0x124, 0xF);
      ss += DPPF(ss, 0x128, 0xF);
      const bool isq = cb < 512;
      const float rs = rsqrtf(ss * (1.f / 64.f) + 1e-6f) * (isq ? (-0.125f * 1.4426950408889634f) : 1.f);
      const f32x4 w = ec.w;
      int pk = __builtin_amdgcn_cvt_pk_fp8_f32(v[0] * rs * w[0], v[1] * rs * w[1], 0, false);
      pk = __builtin_amdgcn_cvt_pk_fp8_f32(v[2] * rs * w[2], v[3] * rs * w[3], pk, true);
      *(uint32_t*)((uint8_t*)(isq ? p.q() : p.k()) + (size_t)row * 512 + (col & 511)) = (uint32_t)pk;
    } else if (cb < 2048) {
      half4 o;
#pragma unroll
      for (int i = 0; i < 4; ++i) o[i] = (half_t)v[i];
      if (cb >= 1536) *(half4*)(p.cb() + (size_t)row * 512 + (col & 511)) = o;
    } else if (cb < 3072) {
      f32x4 o;
#pragma unroll
      for (int i = 0; i < 4; ++i) o[i] = DPPF(v[i], 0x128, 0xF);
      if (cin < 32) {
        half4 u;
#pragma unroll
        for (int i = 0; i < 4; ++i) u[i] = (half_t)(v[i] * o[i]);
        *(half4*)(p.uu() + (size_t)row * 512 + ((cb - 2048) >> 1) + cin) = u;
      }
    } else if (cb < 3584) {
      half4 o;
#pragma unroll
      for (int i = 0; i < 4; ++i) o[i] = (half_t)v[i];
      *(half4*)(p.iq() + (size_t)row * 512 + (col - 3072)) = o;
    } else if (cb == 3584) {
      half4 o;
#pragma unroll
      for (int i = 0; i < 4; ++i) o[i] = (half_t)v[i];
      *(half4*)(p.ik() + (size_t)(row >> 5) * 2048 + (cin >> 4) * 512 + ((cin >> 3) & 1) * 256 + (row & 31) * 8 + (cin & 7)) = o;
    } else if (cb == 3648 && cin < 8) {
      *(f32x4*)(p.iw() + (size_t)row * 8 + cin) = v;
    }
  }
};

struct EpiOut {
  Params p;
  static constexpr bool kVT = false;
  static constexpr bool kTopk = false;
  __host__ __device__ __forceinline__ void after_tile(int, int, uint32_t*) const {}
  __host__ __device__ __forceinline__ const int8_t* a8() const { return p.h8(); }
  __host__ __device__ __forceinline__ const int8_t* b8() const { return p.wt8(); }
  __host__ __device__ __forceinline__ const float* rsc() const { return p.hs1(); }
  __host__ __device__ __forceinline__ const float* csc() const { return p.cs8(); }
  struct Col {
    f32x4 g;
  };
  struct Pre {
    f32x4 x;
  };
  __host__ __device__ __forceinline__ Col colctx(int brow, int col) const {
    return Col{*(const f32x4*)(p.mod() + (brow >> 13) * 6144 + 2048 + col)};
  }
  __host__ __device__ __forceinline__ Pre prefetch(int row, int col) const {
    return Pre{*(const f32x4*)(p.x + (size_t)row * 1024 + col)};
  }
  __host__ __device__ __forceinline__ void operator()(const f32x4& v, int row, int col, int lane, const Col& ec, const Pre& pr) const {
    const f32x4 r = pr.x + ec.g * v;
    half4 o;
#pragma unroll
    for (int i = 0; i < 4; ++i) o[i] = (half_t)r[i];
    *(half4*)(p.x1h() + (size_t)row * 1024 + col) = o;
  }
};

struct EpiPs {
  Params p;
  half_t* scr;
  static constexpr bool kVT = false;
  static constexpr bool kTopk = true;
  __host__ __device__ __forceinline__ const int8_t* a8() const { return p.h2q(); }
  __host__ __device__ __forceinline__ const int8_t* b8() const { return p.wtp8(); }
  __host__ __device__ __forceinline__ const float* rsc() const { return p.hscale(); }
  __host__ __device__ __forceinline__ const float* csc() const { return p.csp(); }
  struct Col {};
  struct Pre {};
  __host__ __device__ __forceinline__ Col colctx(int, int) const { return Col{}; }
  __host__ __device__ __forceinline__ Pre prefetch(int, int) const { return Pre{}; }
  __host__ __device__ __forceinline__ void operator()(const f32x4& v, int row, int col, int lane, const Col&, const Pre&) const {
    half4 o;
#pragma unroll
    for (int i = 0; i < 4; ++i) o[i] = (half_t)v[i];
    *(half4*)(scr + (row & 255) * 256 + (col & 255)) = o;
  }
  __device__ __forceinline__ void after_tile(int brow, int head, uint32_t* sm) const {
    const int lane = TIDX & 63, wave = TIDX >> 6;
    asm volatile("s_waitcnt vmcnt(0)" ::: "memory");
    __syncthreads();
    const int tl = wave * 32 + (lane >> 1);
    topk_item(p, sm + (wave * 64 + lane) * 27, scr + tl * 256 + (lane & 1) * 128, brow + tl, head * 2 + (lane & 1), lane);
    __syncthreads();
  }
};

template <class Epi, int N8>
__device__ __forceinline__ void phase_gemm(const half_t* A, const half_t* Bt, int nN, half_t* sm, const Epi& epi, int bid, int nblk) {
  const int nM = T_TOK / 256;
  const int nwg = nM * nN;
  for (int w0 = bid; w0 < nwg; w0 += nblk) {
    int wgid = w0;
    {
      const int q = nwg / 8, r = nwg % 8, xcd = wgid % 8, off = wgid / 8;
      wgid = (xcd < r ? xcd * (q + 1) : r * (q + 1) + (xcd - r) * q) + off;
    }
    const int nig = 8 * nN, gid = wgid / nig, fm = gid * 8;
    const int gsz = min(nM - fm, 8);
    const int pm = fm + ((wgid % nig) % gsz), pn = (wgid % nig) / gsz;
    if (N8 > 0 && pn < N8)
      gemm8_tile<Epi, true>((const half_t*)epi.a8(), (const half_t*)epi.b8(), 512, pm * 256, pn * 256, sm, epi);
    else
      gemm8_tile<Epi, false>(A, Bt, 1024, pm * 256, pn * 256, sm, epi);
    if (Epi::kTopk) epi.after_tile(pm * 256, pn, (uint32_t*)sm);
  }
}

__device__ __forceinline__ size_t mask_unit(int b, int qb) {
  return (size_t)b * (65536ull * 528ull) + 65536ull * (size_t)(qb * (qb + 1) / 2);
}
__device__ __forceinline__ size_t mask_addr(int b, int t, int tile, int g, int hi) {
  const int qb = t >> 8, ntiles = 4 * qb + 4;
  return mask_unit(b, qb) + (size_t)(((t & 255) >> 5) * ntiles + tile) * 2048 + (g >> 2) * 1024 + (hi * 32 + (t & 31)) * 16 + (g & 3) * 4;
}
__device__ __forceinline__ uint32_t fkey(float f) {
  uint32_t u = __float_as_uint(f);
  return (u & 0x80000000u) ? ~u : (u | 0x80000000u);
}

typedef unsigned short us2 __attribute__((ext_vector_type(2)));
__device__ __forceinline__ uint32_t pk_subsat(uint32_t a, uint32_t b) {
  return __builtin_bit_cast(uint32_t, __builtin_elementwise_sub_sat(__builtin_bit_cast(us2, a), __builtin_bit_cast(us2, b)));
}
__device__ __forceinline__ uint32_t pk_sub(uint32_t a, uint32_t b) {
  return __builtin_bit_cast(uint32_t, (us2)(__builtin_bit_cast(us2, a) - __builtin_bit_cast(us2, b)));
}
__device__ __forceinline__ uint32_t pk_min(uint32_t a, uint32_t b) {
  return __builtin_bit_cast(uint32_t, __builtin_elementwise_min(__builtin_bit_cast(us2, a), __builtin_bit_cast(us2, b)));
}
__device__ __forceinline__ uint32_t pk_max(uint32_t a, uint32_t b) {
  return __builtin_bit_cast(uint32_t, __builtin_elementwise_max(__builtin_bit_cast(us2, a), __builtin_bit_cast(us2, b)));
}
__device__ __forceinline__ uint32_t pk_add(uint32_t a, uint32_t b) {
  return __builtin_bit_cast(uint32_t, (us2)(__builtin_bit_cast(us2, a) + __builtin_bit_cast(us2, b)));
}
typedef short s16x2 __attribute__((ext_vector_type(2)));

#define CEX(a, b)                      \
  {                                    \
    const uint32_t _h = max(a, b);     \
    const uint32_t _l = min(a, b);     \
    a = _h;                            \
    b = _l;                            \
  }
#define IDX_COUNT(dst, thr_m1_x2)                                                                 \
  {                                                                                               \
    uint32_t _c0 = 0, _c1 = 0, _c2 = 0, _c3 = 0;                                                  \
    _Pragma("unroll") for (int g = 0; g < 16; g += 2) {                                           \
      if (g < NG) {                                                                               \
        _c0 = pk_add(_c0, pk_min(pk_subsat(kx[4 * g + 0], (thr_m1_x2)), one));                    \
        _c1 = pk_add(_c1, pk_min(pk_subsat(kx[4 * g + 1], (thr_m1_x2)), one));                    \
        _c2 = pk_add(_c2, pk_min(pk_subsat(kx[4 * g + 2], (thr_m1_x2)), one));                    \
        _c3 = pk_add(_c3, pk_min(pk_subsat(kx[4 * g + 3], (thr_m1_x2)), one));                    \
        _c0 = pk_add(_c0, pk_min(pk_subsat(kx[4 * g + 4], (thr_m1_x2)), one));                    \
        _c1 = pk_add(_c1, pk_min(pk_subsat(kx[4 * g + 5], (thr_m1_x2)), one));                    \
        _c2 = pk_add(_c2, pk_min(pk_subsat(kx[4 * g + 6], (thr_m1_x2)), one));                    \
        _c3 = pk_add(_c3, pk_min(pk_subsat(kx[4 * g + 7], (thr_m1_x2)), one));                    \
      }                                                                                           \
    }                                                                                             \
    const uint32_t _c = pk_add(pk_add(_c0, _c1), pk_add(_c2, _c3));                               \
    int _s = (int)((_c & 0xffffu) + (_c >> 16));                                                  \
    dst = wave_sum_dpp(_s);                                                                       \
  }
#define IDX_COUNT2(dstA, dstB, thrA_m1_x2, thrB_m1_x2)                                            \
  {                                                                                               \
    uint32_t _a0 = 0, _a1 = 0, _b0 = 0, _b1 = 0;                                                  \
    _Pragma("unroll") for (int g = 0; g < 16; g += 2) {                                           \
      if (g < NG) {                                                                               \
        _Pragma("unroll") for (int i = 0; i < 8; i += 2) {                                        \
          _a0 = pk_add(_a0, pk_min(pk_subsat(kx[4 * g + i], (thrA_m1_x2)), one));                 \
          _a1 = pk_add(_a1, pk_min(pk_subsat(kx[4 * g + i + 1], (thrA_m1_x2)), one));             \
          _b0 = pk_add(_b0, pk_min(pk_subsat(kx[4 * g + i], (thrB_m1_x2)), one));                 \
          _b1 = pk_add(_b1, pk_min(pk_subsat(kx[4 * g + i + 1], (thrB_m1_x2)), one));             \
        }                                                                                         \
      }                                                                                           \
    }                                                                                             \
    const uint32_t _ca = pk_add(_a0, _a1), _cb = pk_add(_b0, _b1);                                \
    const int _s = (int)(((_ca & 0xffffu) + (_ca >> 16)) | (((_cb & 0xffffu) + (_cb >> 16)) << 16)); \
    const int _t = wave_sum_dpp(_s);                                                              \
    dstA = _t & 0xffff;                                                                           \
    dstB = (int)((uint32_t)_t >> 16);                                                             \
  }

__device__ __forceinline__ float relu1(float x) { return __int_as_float(max(__float_as_int(x), 0)); }

__device__ __forceinline__ void phase_index(const Params& p, half_t* sc, int bid, int nblk) {
  const int tid = TIDX, lane = tid & 63, wave = tid >> 6;
  const int half = lane >> 5, l31 = lane & 31;
  const float idx_scale = 0.125f * 0.35355339059327373f;
  half_t* scl = sc + half * 8192 + l31;
  const half_t hninf = (half_t)NEG_INF;
  half8 an[2][4];
  f32x4 wn[2][4];
  half8 nA[4], nB[4];
#define IDX_G(JJ) (4095 - ((JJ) * nblk + (((JJ) & 1) ? (nblk - 1 - bid) : bid)))
#define IDX_PREFETCH(GG)                                                                                         \
  {                                                                                                              \
    const int pg_ = (GG) >> 2, tb_ = ((GG) & 3) * SEQ, t0_ = pg_ * 8;                                            \
    _Pragma("unroll") for (int m = 0; m < 2; ++m) {                                                              \
      const int r = l31;                                                                                         \
      const int qq = 2 * (r >> 4) + ((r >> 2) & 1), hh = (r & 3) + 4 * ((r >> 3) & 1);                           \
      const half_t* ap = p.iq() + (size_t)(tb_ + t0_ + 4 * m + qq) * 512 + hh * 64 + half * 8;                   \
      _Pragma("unroll") for (int ks = 0; ks < 4; ++ks) an[m][ks] = *(const half8*)(ap + ks * 16);                \
        \
      const f32x4* w0 = (const f32x4*)(p.iw() + (size_t)(tb_ + t0_ + 4 * m + half) * 8);                         \
      const f32x4* w1 = (const f32x4*)(p.iw() + (size_t)(tb_ + t0_ + 4 * m + 2 + half) * 8);                     \
      wn[m][0] = w0[0];                                                                                          \
      wn[m][1] = w0[1];                                                                                          \
      wn[m][2] = w1[0];                                                                                          \
      wn[m][3] = w1[1];                                                                                          \
    }                                                                                                            \
    const int nkt_ = ((t0_ + 7) >> 5) + 1;                                                                       \
    const int kB_ = (wave + NWAVE < nkt_) ? wave + NWAVE : wave;                                                 \
    const half_t* bpA = p.ik() + (size_t)((tb_ >> 5) + wave) * 2048 + lane * 8;                                  \
    const half_t* bpB = p.ik() + (size_t)((tb_ >> 5) + kB_) * 2048 + lane * 8;                                   \
    _Pragma("unroll") for (int ks = 0; ks < 4; ++ks) {                                                           \
      nA[ks] = *(const half8*)(bpA + ks * 512);                                                                  \
      nB[ks] = *(const half8*)(bpB + ks * 512);                                                                  \
    }                                                                                                            \
  }
  const int njj = (4096 + nblk - 1) / nblk;
  {
    int g0 = -1;
    for (int j = 0; j < njj && g0 < 0; ++j)
      if (IDX_G(j) >= 0) g0 = IDX_G(j);
    if (g0 < 0) return;
    IDX_PREFETCH(g0)
  }
  LAS int* tcnt = (LAS int*)((LAS char*)sc + 131072 + 16);
  if (tid == 0) *tcnt = NWAVE;
  __syncthreads();
  for (int jj = 0; jj < njj; ++jj) {
    const int G = IDX_G(jj);
    if (G < 0) continue;
    const int pgrp = G >> 2, b = G & 3;
    const int t0 = pgrp * 8, tokbase = b * SEQ;
    {
      half8 a[2][4];
      float wv[2][16];
#pragma unroll
      for (int m = 0; m < 2; ++m) {
#pragma unroll
        for (int ks = 0; ks < 4; ++ks) a[m][ks] = an[m][ks];
#pragma unroll
        for (int g = 0; g < 16; ++g) wv[m][g] = wn[m][g >> 2][g & 3] * idx_scale;
      }
      const int nkt = ((t0 + 7) >> 5) + 1;
      int Pcur = wave, Pn;
      {
        int tk = 0;
        if (lane == 0) tk = __hip_atomic_fetch_add(tcnt, 1, __ATOMIC_RELAXED, __HIP_MEMORY_SCOPE_WORKGROUP);
        Pn = __builtin_amdgcn_readfirstlane(tk);
      }
      for (;;) {
        const int kt = 16 * (Pcur >> 3) + (Pcur & 7);
        if (kt >= nkt) break;
        const bool has2 = (kt + NWAVE < nkt);
        const int sA = kt * 32, sB = has2 ? (kt + NWAVE) * 32 : sA;
        half8 bA[4], bB[4];
#pragma unroll
        for (int ks = 0; ks < 4; ++ks) {
          bA[ks] = nA[ks];
          bB[ks] = nB[ks];
        }
        int tkn = 0;
        if (lane == 0) tkn = __hip_atomic_fetch_add(tcnt, 1, __ATOMIC_RELAXED, __HIP_MEMORY_SCOPE_WORKGROUP);
        {
          const int k2 = 16 * (Pn >> 3) + (Pn & 7);
          const int kA2 = (k2 < nkt) ? k2 : kt;
          const int kB2 = (k2 + NWAVE < nkt) ? k2 + NWAVE : kA2;
          const half_t* bpA = p.ik() + (size_t)((tokbase >> 5) + kA2) * 2048 + lane * 8;
          const half_t* bpB = p.ik() + (size_t)((tokbase >> 5) + kB2) * 2048 + lane * 8;
#pragma unroll
          for (int ks = 0; ks < 4; ++ks) {
            nA[ks] = *(const half8*)(bpA + ks * 512);
            nB[ks] = *(const half8*)(bpB + ks * 512);
          }
        }
        __builtin_amdgcn_sched_barrier(0);
        f32x16 accA[2], accB[2];
#pragma unroll
        for (int m = 0; m < 2; ++m)
#pragma unroll
          for (int g = 0; g < 16; ++g) {
            accA[m][g] = 0.f;
            accB[m][g] = 0.f;
          }
#pragma unroll
        for (int ks = 0; ks < 4; ++ks)
#pragma unroll
          for (int m = 0; m < 2; ++m) {
            accA[m] = __builtin_amdgcn_mfma_f32_32x32x16_f16(a[m][ks], bA[ks], accA[m], 0, 0, 0);
            accB[m] = __builtin_amdgcn_mfma_f32_32x32x16_f16(a[m][ks], bB[ks], accB[m], 0, 0, 0);
          }
#pragma unroll
        for (int m = 0; m < 2; ++m) {
          f32x2 a_lo2 = {0.f, 0.f}, a_hi2 = {0.f, 0.f}, b_lo2 = {0.f, 0.f}, b_hi2 = {0.f, 0.f};
#pragma unroll
          for (int g = 0; g < 8; g += 2) {
            const f32x2 w2 = {wv[m][g], wv[m][g + 1]};
            a_lo2 += w2 * (f32x2){relu1(accA[m][g]), relu1(accA[m][g + 1])};
            b_lo2 += w2 * (f32x2){relu1(accB[m][g]), relu1(accB[m][g + 1])};
          }
#pragma unroll
          for (int g = 8; g < 16; g += 2) {
            const f32x2 w2 = {wv[m][g], wv[m][g + 1]};
            a_hi2 += w2 * (f32x2){relu1(accA[m][g]), relu1(accA[m][g + 1])};
            b_hi2 += w2 * (f32x2){relu1(accB[m][g]), relu1(accB[m][g + 1])};
          }
          const float a_lo = a_lo2[0] + a_lo2[1], a_hi = a_hi2[0] + a_hi2[1];
          const float b_lo = b_lo2[0] + b_lo2[1], b_hi = b_hi2[0] + b_hi2[1];
          const int qa = 4 * m + half, qb = 4 * m + 2 + half;
          const int keyA = sA + l31, keyB = sB + l31;
          half_t* scA = scl + (4 * m) * 8192 + sA;
          half_t* scB = scl + (4 * m) * 8192 + sB;
          if (sB + 31 <= t0) {
            scA[0] = (half_t)a_lo;
            scA[2 * 8192] = (half_t)a_hi;
            scB[0] = (half_t)b_lo;
            scB[2 * 8192] = (half_t)b_hi;
          } else {
            scA[0] = (keyA <= t0 + qa) ? (half_t)a_lo : hninf;
            scA[2 * 8192] = (keyA <= t0 + qb) ? (half_t)a_hi : hninf;
            if (has2) {
              scB[0] = (keyB <= t0 + qa) ? (half_t)b_lo : hninf;
              scB[2 * 8192] = (keyB <= t0 + qb) ? (half_t)b_hi : hninf;
            }
          }
        }
        Pcur = Pn;
        Pn = __builtin_amdgcn_readfirstlane(tkn);
      }
      const int fill_lo = 32 * nkt, fill_hi = 512 * ((t0 + 8 + 511) >> 9);
#pragma unroll
      for (int q = 0; q < 8; ++q)
        for (int kk = fill_lo + tid; kk < fill_hi; kk += NTHR) sc[q * 8192 + kk] = hninf;
      {
        int gn = G;
        for (int j = jj + 1; j < njj; ++j)
          if (IDX_G(j) >= 0) {
            gn = IDX_G(j);
            break;
          }
        IDX_PREFETCH(gn)
      }
    }
    __syncthreads();
    if (tid == 0) *tcnt = NWAVE;
    {
      const int t = __builtin_amdgcn_readfirstlane(t0 + wave), n = t + 1;
      const int rowlen = 256 * ((t >> 8) + 1);
      const int NG = (n + 511) >> 9;
      const half_t* row = sc + wave * 8192;
      if (n <= 256) {
        uint32_t w = 0xFFFFFFFFu;
#pragma unroll
        for (int i = 0; i < 4; ++i)
          if (lane * 4 + i >= n) w -= 0xFFu << (8 * i);
        *(uint32_t*)(p.maskb() + mask_addr(b, t, lane >> 4, (lane & 15) >> 1, lane & 1)) = w;
        __syncthreads();
      } else {
        uint32_t one = 0x00010001u;
        asm volatile("" : "+v"(one));
        uint32_t kx[64];
#pragma unroll
        for (int g = 0; g < 16; ++g) {
          if (g < NG) {
            const u32x4 v = *(const u32x4*)(row + (g * 64 + lane) * 8);
#pragma unroll
            for (int i = 0; i < 4; ++i) {
              const uint32_t x = v[i];
              const uint32_t m = __builtin_bit_cast(uint32_t, __builtin_bit_cast(s16x2, x) >> 15);
              kx[4 * g + i] = x ^ (m | 0x80008000u);
            }
          } else {
#pragma unroll
            for (int i = 0; i < 4; ++i) kx[4 * g + i] = 0u;
          }
        }
        __syncthreads();
        uint32_t sm4[4] = {0u, 0u, 0u, 0u};
#pragma unroll
        for (int g = 0; g < 16; ++g) {
          if (g < NG) {
#pragma unroll
            for (int i = 0; i < 4; ++i) sm4[i] = pk_max(sm4[i], kx[4 * g + i]);
          }
        }
        const uint32_t mx = pk_max(pk_max(sm4[0], sm4[1]), pk_max(sm4[2], sm4[3]));
        const uint32_t mn = pk_min(pk_min(sm4[0], sm4[1]), pk_min(sm4[2], sm4[3]));
        int mxi = (int)max(mx & 0xffffu, mx >> 16);
        int mni = (int)min(mn & 0xffffu, mn >> 16);
        mxi = wave_max_dpp(mxi);
        mni = 0xffff - wave_max_dpp(0xffff - mni);
        uint32_t lo = (uint32_t)__builtin_amdgcn_readfirstlane(mni), hi = (uint32_t)__builtin_amdgcn_readfirstlane(mxi) + 1u;
        if (lo < 1u) lo = 1u;
        uint32_t candA, candB;
        {
          uint32_t e8[8];
#pragma unroll
          for (int i = 0; i < 4; ++i) {
            e8[2 * i] = sm4[i] & 0xffffu;
            e8[2 * i + 1] = sm4[i] >> 16;
          }
          CEX(e8[0], e8[2]); CEX(e8[1], e8[3]); CEX(e8[4], e8[6]); CEX(e8[5], e8[7]);
          CEX(e8[0], e8[4]); CEX(e8[1], e8[5]); CEX(e8[2], e8[6]); CEX(e8[3], e8[7]);
          CEX(e8[0], e8[1]); CEX(e8[2], e8[3]); CEX(e8[4], e8[5]); CEX(e8[6], e8[7]);
          CEX(e8[2], e8[4]); CEX(e8[3], e8[5]);
          CEX(e8[1], e8[4]); CEX(e8[3], e8[6]);
          CEX(e8[1], e8[2]); CEX(e8[3], e8[4]); CEX(e8[5], e8[6]);
          candB = (uint32_t)(wave_sum_dpp((int)e8[2]) + 32) >> 6;
          candA = (uint32_t)(wave_sum_dpp((int)e8[3]) + 32) >> 6;
        }
        int clo = 0, chi = 0;
        float flo = __log2f((float)(NG * 512)) - 8.0f, fhi = -9.0f;
        int side = 0, iter = 2;
        bool lo_probed = false, done = false;
        if (hi - lo > 1u) {
          const uint32_t ca = (uint32_t)__builtin_amdgcn_readfirstlane((int)min(max(candA, lo + 1u), hi - 1u));
          const uint32_t cb = (uint32_t)__builtin_amdgcn_readfirstlane((int)min(max(candB, lo + 1u), hi - 1u));
          const uint32_t am1 = ca - 1u, bm1 = cb - 1u;
          int na, nb;
          IDX_COUNT2(na, nb, am1 | (am1 << 16), bm1 | (bm1 << 16));
#define IDX_APPLY(CAND, C)                                  \
  {                                                         \
    const float fc_ = __log2f((float)(C) + 0.5f) - 8.0f;    \
    if ((C) >= 256) {                                       \
      lo = (CAND);                                          \
      clo = (C);                                            \
      lo_probed = true;                                     \
      flo = fc_;                                            \
      side = 1;                                             \
      if ((C) == 256) done = true;                          \
    } else {                                                \
      hi = (CAND);                                          \
      chi = (C);                                            \
      fhi = fc_;                                            \
      side = 2;                                             \
    }                                                       \
  }
          IDX_APPLY(ca, na)
          if (!done && cb > lo && cb < hi) IDX_APPLY(cb, nb)
#undef IDX_APPLY
        }
#pragma unroll 1
        while (!done && hi - lo > 1u) {
          uint32_t cand;
          if (iter >= 14) {
            cand = (lo + hi) >> 1;
          } else {
            const float tt = flo * __builtin_amdgcn_rcpf(flo - fhi);
            cand = lo + (uint32_t)(tt * (float)(hi - lo) + 0.5f);
            cand = min(max(cand, lo + 1u), hi - 1u);
          }
          cand = (uint32_t)__builtin_amdgcn_readfirstlane((int)cand);
          const uint32_t tm1 = cand - 1u;
          const uint32_t tx2 = tm1 | (tm1 << 16);
          int c;
          IDX_COUNT(c, tx2);
          const float fc = __log2f((float)c + 0.5f) - 8.0f;
          if (c >= 256) {
            lo = cand;
            clo = c;
            lo_probed = true;
            if (c == 256) break;
            flo = fc;
            if (side == 1 && iter >= 2) fhi *= 0.5f;
            side = 1;
          } else {
            hi = cand;
            chi = c;
            fhi = fc;
            if (side == 2 && iter >= 2) flo *= 0.5f;
            side = 2;
          }
          ++iter;
        }
        if (!lo_probed) {
          const uint32_t tm1 = lo - 1u;
          const uint32_t tx2 = tm1 | (tm1 << 16);
          IDX_COUNT(clo, tx2);
        }
        const uint32_t T = lo;
        const int cgt = chi, cge = clo;
        int need = 256 - cgt;
        const bool slow = (cge - cgt) > need;
        const uint32_t thr = slow ? (T + 1u) : T;
        const uint32_t thrx = thr | (thr << 16);
        const uint32_t tx = T | (T << 16);
        const uint32_t tm1x = (T - 1u) | ((T - 1u) << 16);
#pragma unroll
        for (int g = 0; g < 16; ++g) {
          if (g * 512 < rowlen) {
            uint32_t b16[4];
#pragma unroll
            for (int i = 0; i < 4; ++i) b16[i] = pk_min(pk_subsat(thrx, kx[4 * g + i]), one);
            uint32_t d0 = ~(__builtin_amdgcn_perm(b16[1], b16[0], 0x06040200u) * 0xFFu);
            uint32_t d1 = ~(__builtin_amdgcn_perm(b16[3], b16[2], 0x06040200u) * 0xFFu);
            if (slow) {
              uint32_t tb = 0;
#pragma unroll
              for (int i = 0; i < 4; ++i) {
                const uint32_t ge = pk_min(pk_subsat(kx[4 * g + i], tm1x), one);
                const uint32_t gt = pk_min(pk_subsat(kx[4 * g + i], tx), one);
                const uint32_t eq = ge - gt;
                tb |= ((eq & 1u) << (2 * i)) | (((eq >> 16) & 1u) << (2 * i + 1));
              }
              unsigned long long any = __ballot(tb != 0u);
              while (any && need > 0) {
                const int src = __ffsll((long long)any) - 1;
                any &= any - 1;
                uint32_t bits = (uint32_t)__builtin_amdgcn_readlane((int)tb, src);
                while (bits && need > 0) {
                  const int e = __ffs((int)bits) - 1;
                  bits &= bits - 1;
                  if (lane == src) {
                    if (e < 4) d0 |= 0xFFu << (8 * e);
                    else d1 |= 0xFFu << (8 * (e - 4));
                  }
                  --need;
                }
              }
            }
            if ((g * 64 + lane) * 8 < rowlen) {
              uint8_t* tp = p.maskb() + mask_addr(b, t, g * 8 + (lane >> 3), lane & 7, 0);
              *(uint32_t*)tp = d0;
              *(uint32_t*)(tp + 512) = d1;
            }
          }
        }
      }
    }
  }
}

#define ATT_KROW 80
#define ATT_VROW 80
#define ATT_KBUF (64 * ATT_KROW)
#define ATT_VBUF (64 * ATT_VROW)
__device__ __forceinline__ void attn_unit(const Params& p, char* lds, int b, int head, int qb) {
  const int tid = TIDX, lane = tid & 63, wave = tid >> 6;
  const int r32 = lane & 31, hi = lane >> 5;
  const int tokbase = b * SEQ, q0 = qb * 256, q0w = q0 + wave * 32;
  const int ntiles = 4 * qb + 4;
  const int tlast = (q0w + 31) >> 6;
  char* Kb = lds;
  char* Vb = lds + 4 * ATT_KBUF;
  const int srow = tid >> 3, sch = tid & 7;
  const uint8_t* kg = (const uint8_t*)p.k() + (size_t)(tokbase + srow) * 512 + head * 64 + sch * 8;
  const uint8_t* vg = (const uint8_t*)p.vt() + ((size_t)((b * 8 + head) * 64 + srow)) * 8192 + sch * 8;
  const int klds = srow * ATT_KROW + sch * 8, vlds = srow * ATT_VROW + sch * 8;
  typedef int i32x8 __attribute__((ext_vector_type(8)));
  i32x8 qf;
  {
    const uint8_t* qp = (const uint8_t*)p.q() + (size_t)(tokbase + q0w + r32) * 512 + head * 64 + hi * 32;
    const u32x4 qa = *(const u32x4*)qp, qb_ = *(const u32x4*)(qp + 16);
#pragma unroll
    for (int i = 0; i < 4; ++i) {
      qf[i] = (int)qa[i];
      qf[4 + i] = (int)qb_[i];
    }
  }
  const uint8_t* mrow = p.maskb() + mask_unit(b, qb) + (size_t)wave * ntiles * 2048 + lane * 16;
  const unsigned long long wsb_ = (unsigned long long)p.ws;
  const unsigned wb_lo = (unsigned)__builtin_amdgcn_readfirstlane((int)(unsigned)wsb_);
  const unsigned wb_hi = (unsigned)__builtin_amdgcn_readfirstlane((int)(unsigned)(wsb_ >> 32));
  const __amdgpu_buffer_rsrc_t wrs =
      __builtin_amdgcn_make_buffer_rsrc((void*)(((unsigned long long)wb_hi << 32) | wb_lo), 0, 0xFFFFF000u, 0x00020000);
  const int kvo = (int)(unsigned)((unsigned long long)kg - wsb_), vvo = (int)(unsigned)((unsigned long long)vg - wsb_);
  const int mvo = (int)(unsigned)((unsigned long long)mrow - wsb_);
  typedef unsigned att_u32x2 __attribute__((ext_vector_type(2)));
#define ATT_LD8(DST, VOFF, SOFF)                                                              \
  {                                                                                           \
    const att_u32x2 r_ = __builtin_amdgcn_raw_buffer_load_b64(wrs, (VOFF), (SOFF), 0);        \
    DST = make_uint2(r_[0], r_[1]);                                                           \
  }
  const char* kbl = Kb + r32 * ATT_KROW + hi * 32;
  const char* vbl = Vb + r32 * ATT_VROW + hi * 32;
  f32x16 ot0, ot1;
#pragma unroll
  for (int r = 0; r < 16; ++r) {
    ot0[r] = 0.f;
    ot1[r] = 0.f;
  }
  f32x16 c0;
  f32x16 osum;
  i32x8 onesf;
#pragma unroll
  for (int r = 0; r < 16; ++r) {
    osum[r] = 0.f;
    c0[r] = 0.f;
  }
#pragma unroll
  for (int r = 0; r < 8; ++r) onesf[r] = 0x38383838;
  asm volatile("" : "+v"(onesf));

#define ATT_QK(A0, A1, KB)                                                                    \
  {                                                                                           \
    i32x8 kf0, kf1;                                                                           \
    const u32x4 x0 = *(const u32x4*)(KB), x1 = *(const u32x4*)((KB) + 16);                    \
    const u32x4 y0 = *(const u32x4*)((KB) + 32 * ATT_KROW), y1 = *(const u32x4*)((KB) + 32 * ATT_KROW + 16); \
    _Pragma("unroll") for (int i = 0; i < 4; ++i) {                                           \
      kf0[i] = (int)x0[i];                                                                    \
      kf0[4 + i] = (int)x1[i];                                                                \
      kf1[i] = (int)y0[i];                                                                    \
      kf1[4 + i] = (int)y1[i];                                                                \
    }                                                                                         \
    A0 = __builtin_amdgcn_mfma_scale_f32_32x32x64_f8f6f4(kf0, qf, c0, 0, 0, 0, 0, 0, 0);      \
    A1 = __builtin_amdgcn_mfma_scale_f32_32x32x64_f8f6f4(kf1, qf, c0, 0, 0, 0, 0, 0, 0);      \
  }
#define ATT_SOFTMAX_ON(S0_, S1_, PB, MA, MB)                                                        \
  {                                                                                           \
    _Pragma("unroll") for (int i = 0; i < 4; ++i) {                                           \
      const float e0 = __builtin_amdgcn_exp2f(-S0_[4 * i]), e1 = __builtin_amdgcn_exp2f(-S0_[4 * i + 1]);     \
      const float e2 = __builtin_amdgcn_exp2f(-S0_[4 * i + 2]), e3 = __builtin_amdgcn_exp2f(-S0_[4 * i + 3]); \
      const float f0 = __builtin_amdgcn_exp2f(-S1_[4 * i]), f1 = __builtin_amdgcn_exp2f(-S1_[4 * i + 1]);     \
      const float f2 = __builtin_amdgcn_exp2f(-S1_[4 * i + 2]), f3 = __builtin_amdgcn_exp2f(-S1_[4 * i + 3]); \
      s16x2 pk = __builtin_bit_cast(s16x2, e0);        \
      pk = __builtin_amdgcn_cvt_scalef32_pk_fp8_f32(pk, e0, e1, 16.f, false);                 \
      pk = __builtin_amdgcn_cvt_scalef32_pk_fp8_f32(pk, e2, e3, 16.f, true);                  \
      PB[i] = __builtin_bit_cast(int, pk) & (int)MA[i];                                       \
      s16x2 qk = __builtin_bit_cast(s16x2, f0);                                               \
      qk = __builtin_amdgcn_cvt_scalef32_pk_fp8_f32(qk, f0, f1, 16.f, false);                 \
      qk = __builtin_amdgcn_cvt_scalef32_pk_fp8_f32(qk, f2, f3, 16.f, true);                  \
      PB[4 + i] = __builtin_bit_cast(int, qk) & (int)MB[i];                                   \
    }                                                                                         \
  }
#define ATT_PV_ON(PB, VB)                                                                     \
  {                                                                                           \
    i32x8 vf0, vf1;                                                                           \
    const u32x4 x0 = *(const u32x4*)(VB), x1 = *(const u32x4*)((VB) + 16);                    \
    const u32x4 y0 = *(const u32x4*)((VB) + 32 * ATT_VROW), y1 = *(const u32x4*)((VB) + 32 * ATT_VROW + 16); \
    _Pragma("unroll") for (int i = 0; i < 4; ++i) {                                           \
      vf0[i] = (int)x0[i];                                                                    \
      vf0[4 + i] = (int)x1[i];                                                                \
      vf1[i] = (int)y0[i];                                                                    \
      vf1[4 + i] = (int)y1[i];                                                                \
    }                                                                                         \
    ot0 = __builtin_amdgcn_mfma_scale_f32_32x32x64_f8f6f4(vf0, PB, ot0, 0, 0, 0, 0, 0, 0);    \
    ot1 = __builtin_amdgcn_mfma_scale_f32_32x32x64_f8f6f4(vf1, PB, ot1, 0, 0, 0, 0, 0, 0);    \
    osum = __builtin_amdgcn_mfma_scale_f32_32x32x64_f8f6f4(onesf, PB, osum, 0, 0, 0, 0, 0, 0); \
  }

  uint2 k0B = *(const uint2*)kg, v0B = *(const uint2*)vg;
  uint2 k1B = *(const uint2*)(kg + (size_t)64 * 512);
  uint2 v1B = *(const uint2*)(kg + (size_t)2 * 64 * 512);
  __builtin_amdgcn_sched_barrier(0);
  u32x4 mna, mnb, mXa, mXb;
  f32x16 s0, s1;
  mna = *(const u32x4*)mrow;
  mnb = *(const u32x4*)(mrow + 1024);
  uint2 k0A = *(const uint2*)(kg + (size_t)3 * 64 * 512);
  uint2 k1A = *(const uint2*)(kg + (size_t)min(4, ntiles - 1) * 64 * 512);
  uint2 v0A = *(const uint2*)(vg + 64);
  uint2 v1A = *(const uint2*)(vg + 2 * 64);
  mXa = *(const u32x4*)(mrow + 2048);
  mXb = *(const u32x4*)(mrow + 2048 + 1024);
  __builtin_amdgcn_sched_barrier(0);
  *(uint2*)(Kb + klds) = k0B;
  *(uint2*)(Vb + vlds) = v0B;
  *(uint2*)(Kb + ATT_KBUF + klds) = k1B;
  *(uint2*)(Kb + 2 * ATT_KBUF + klds) = v1B;
  u32x4 mYa = mna, mYb = mnb;
  {
    __syncthreads();
    ATT_QK(s0, s1, kbl);
    __syncthreads();
  }
#define ATT_COMPUTE(T, KS, VS, SC0, SC1, SN0, SN1, PW, PR, MHA, MHB, MLA, MLB)                                 \
  {                                                                                                           \
    const int t = (T);                                                                                        \
    {                                                                                                         \
      const int tk = min(t + 2, ntiles - 1);                                                                  \
      MLA = __builtin_amdgcn_raw_buffer_load_b128(wrs, mvo, tk * 2048, 0);                                    \
      MLB = __builtin_amdgcn_raw_buffer_load_b128(wrs, mvo + 1024, tk * 2048, 0);                             \
    }                                                                                                         \
    const bool do_next = (t + 1 <= tlast) && (t + 1 < ntiles);                                                \
    const bool do_cur = (t <= tlast);                                                                         \
    const bool do_prev = (t >= 1) && (t - 1 <= tlast);                                                        \
    const char* vbp = vbl + (VS) * ATT_VBUF;                                                       \
    const char* kbq = kbl + (KS) * ATT_KBUF;                                                       \
    if (do_next && do_cur && do_prev) {                                                                       \
      __builtin_amdgcn_s_setprio(1);                                                                          \
        \
      const u32x4 kx0 = *(const u32x4*)(kbq), kx1 = *(const u32x4*)(kbq + 16);                                \
      const u32x4 ky0 = *(const u32x4*)(kbq + 32 * ATT_KROW), ky1 = *(const u32x4*)(kbq + 32 * ATT_KROW + 16); \
      const u32x4 vx0 = *(const u32x4*)(vbp), vx1 = *(const u32x4*)(vbp + 16);                                \
      const u32x4 vy0 = *(const u32x4*)(vbp + 32 * ATT_VROW), vy1 = *(const u32x4*)(vbp + 32 * ATT_VROW + 16); \
      __builtin_amdgcn_sched_barrier(0);                                                                      \
      i32x8 kf0, kf1, vf0, vf1;                                                                               \
      _Pragma("unroll") for (int i = 0; i < 4; ++i) {                                                         \
        kf0[i] = (int)kx0[i];                                                                                 \
        kf0[4 + i] = (int)kx1[i];                                                                             \
        kf1[i] = (int)ky0[i];                                                                                 \
        kf1[4 + i] = (int)ky1[i];                                                                             \
        vf0[i] = (int)vx0[i];                                                                                 \
        vf0[4 + i] = (int)vx1[i];                                                                             \
        vf1[i] = (int)vy0[i];                                                                                 \
        vf1[4 + i] = (int)vy1[i];                                                                             \
      }                                                                                                       \
      SN0 = __builtin_amdgcn_mfma_scale_f32_32x32x64_f8f6f4(kf0, qf, c0, 0, 0, 0, 0, 0, 0);                   \
      SN1 = __builtin_amdgcn_mfma_scale_f32_32x32x64_f8f6f4(kf1, qf, c0, 0, 0, 0, 0, 0, 0);                   \
      osum = __builtin_amdgcn_mfma_scale_f32_32x32x64_f8f6f4(onesf, PR, osum, 0, 0, 0, 0, 0, 0);              \
      ATT_SOFTMAX_ON(SC0, SC1, PW, mna, mnb);                                                                 \
      ot0 = __builtin_amdgcn_mfma_scale_f32_32x32x64_f8f6f4(vf0, PR, ot0, 0, 0, 0, 0, 0, 0);                  \
      ot1 = __builtin_amdgcn_mfma_scale_f32_32x32x64_f8f6f4(vf1, PR, ot1, 0, 0, 0, 0, 0, 0);                  \
      __builtin_amdgcn_s_setprio(0);                                                                          \
    } else {                                                                                                  \
      if (do_next) ATT_QK(SN0, SN1, kbq);                                                                     \
      if (do_cur) ATT_SOFTMAX_ON(SC0, SC1, PW, mna, mnb);                                                     \
      if (do_prev) ATT_PV_ON(PR, vbp);                                                                        \
    }                                                                                                         \
    mna = MHA;                                                                                                \
    mnb = MHB;                                                                                                \
  }
#define ATT_PAIR(T, TM, K0H, K1H, V0H, V1H, K0L, K1L, V0L, V1L)                                               \
  {                                                                                                           \
    {                                                                                                         \
      const int ta = min((T) + 5, ntiles - 1), tb = min((T) + 6, ntiles - 1);                                 \
      const int tc = min((T) + 3, ntiles - 1), td = min((T) + 4, ntiles - 1);                                 \
      ATT_LD8(K0L, kvo, ta * (64 * 512))                                                                      \
      ATT_LD8(K1L, kvo, tb * (64 * 512))                                                                      \
      ATT_LD8(V0L, vvo, tc * 64)                                                                              \
      ATT_LD8(V1L, vvo, td * 64)                                                                              \
    }                                                                                                         \
    ATT_COMPUTE((T), ((TM) + 1) & 3, ((TM) + 3) & 3, s0, s1, u0, u1, pa, pb, mXa, mXb, mYa, mYb)              \
    ATT_COMPUTE((T) + 1, ((TM) + 2) & 3, (TM) & 3, u0, u1, s0, s1, pb, pa, mYa, mYb, mXa, mXb)                \
                     \
    *(uint2*)(Kb + (((TM) + 3) & 3) * ATT_KBUF + klds) = K0H;                                                 \
    *(uint2*)(Kb + ((TM) & 3) * ATT_KBUF + klds) = K1H;                                                       \
    *(uint2*)(Vb + (((TM) + 1) & 3) * ATT_VBUF + vlds) = V0H;                                                 \
    *(uint2*)(Vb + (((TM) + 2) & 3) * ATT_VBUF + vlds) = V1H;                                                 \
    __syncthreads();                                                                                          \
  }
  {
    f32x16 u0, u1;
    i32x8 pa, pb;
#pragma unroll
    for (int r = 0; r < 16; ++r) {
      u0[r] = 0.f;
      u1[r] = 0.f;
    }
#pragma unroll
    for (int j8 = 0; j8 < 8; ++j8) {
      pa[j8] = 0;
      pb[j8] = 0;
    }
    for (int t4 = 0; t4 < ntiles; t4 += 4) {
      ATT_PAIR(t4, 0, k0A, k1A, v0A, v1A, k0B, k1B, v0B, v1B)
      ATT_PAIR(t4 + 2, 2, k0B, k1B, v0B, v1B, k0A, k1A, v0A, v1A)
    }
    if (tlast == ntiles - 1) {
      ATT_PV_ON(pb, vbl + 3 * ATT_VBUF);
    }
    __syncthreads();
  }
#undef ATT_COMPUTE
#undef ATT_PAIR
#undef ATT_QK
#undef ATT_SOFTMAX_ON
#undef ATT_PV_ON
#undef ATT_LD8
  const float inv = 1.f / osum[0];
  half_t* op = p.yattn() + (size_t)(tokbase + q0w + r32) * 512 + head * 64 + hi * 4;
#pragma unroll
  for (int g = 0; g < 4; ++g) {
    half4 o0, o1;
#pragma unroll
    for (int i = 0; i < 4; ++i) {
      o0[i] = (half_t)(ot0[4 * g + i] * inv);
      o1[i] = (half_t)(ot1[4 * g + i] * inv);
    }
    *(half4*)(op + 8 * g) = o0;
    *(half4*)(op + 32 + 8 * g) = o1;
  }
}

__device__ __forceinline__ void phase_attn(const Params& p, char* lds, int bid, int nblk) {
  __builtin_amdgcn_s_setreg(1 | (23 << 6), 1);
  for (int task = bid; task < 512; task += nblk) {
    const int x = task & 7, l = (task >> 3) & 31, k = task >> 8;
    const int head = l & 7, c = x * 8 + (l >> 3) * 2 + k;
    const int b = c & 3, pq = c >> 2;
    attn_unit(p, lds, b, head, 31 - pq);
    attn_unit(p, lds, b, head, pq);
  }
  __builtin_amdgcn_s_setreg(1 | (23 << 6), 0);
}

__device__ __forceinline__ void phase_ymix(const Params& p, int bid, int nblk) {
  const int lane = TIDX & 63, wave = TIDX >> 6;
  const int c0 = lane * 8;
  float wan[8], wcn[8], cbias[8], cw0[8], cw1[8], cw2[8];
#pragma unroll
  for (int i = 0; i < 8; ++i) {
    wan[i] = p.attn_out_norm_w[c0 + i];
    wcn[i] = p.conv_out_norm_w[c0 + i];
    cbias[i] = p.conv_b[c0 + i];
    cw0[i] = p.conv_w[c0 + i];
    cw1[i] = p.conv_w[512 + c0 + i];
    cw2[i] = p.conv_w[1024 + c0 + i];
  }
  const int tok0 = bid * NWAVE + wave, tstep = nblk * NWAVE;
  half8 n_ya, n_u0, n_u1, n_u2, n_cb;
#define YM_LOAD(T)                                                                          \
  {                                                                                         \
    const int t_ = (T);                                                                     \
    n_ya = *(const half8*)(p.yattn() + (size_t)t_ * 512 + c0);                              \
    n_u0 = *(const half8*)(p.uu() + (size_t)t_ * 512 + c0);                                 \
    n_u1 = *(const half8*)(p.uu() + (size_t)max(t_ - 1, 0) * 512 + c0);                     \
    n_u2 = *(const half8*)(p.uu() + (size_t)max(t_ - 2, 0) * 512 + c0);                     \
    n_cb = *(const half8*)(p.cb() + (size_t)t_ * 512 + c0);                                 \
  }
  if (tok0 < T_TOK) YM_LOAD(tok0)
  for (int tok = tok0; tok < T_TOK; tok += tstep) {
    const int pos = tok & 8191;
    const half8 ya = n_ya, u0 = n_u0, cbv = n_cb;
    half8 u1 = n_u1, u2 = n_u2;
    YM_LOAD((tok + tstep < T_TOK) ? tok + tstep : tok)
    if (pos < 1) {
#pragma unroll
      for (int i = 0; i < 8; ++i) u1[i] = (half_t)0.f;
    }
    if (pos < 2) {
#pragma unroll
      for (int i = 0; i < 8; ++i) u2[i] = (half_t)0.f;
    }
    float oa[8], oc[8];
    {
      float f[8], ss = 0.f;
#pragma unroll
      for (int i = 0; i < 8; ++i) {
        f[i] = (float)ya[i];
        ss += f[i] * f[i];
      }
      ss = wave_sum(ss);
      const float rs = rsqrtf(ss * (1.f / 512.f) + 1e-6f);
#pragma unroll
      for (int i = 0; i < 8; ++i) oa[i] = f[i] * rs * wan[i];
    }
    {
      float y[8], ss = 0.f;
#pragma unroll
      for (int i = 0; i < 8; ++i) {
        float acc = cbias[i] + cw0[i] * (float)u2[i] + cw1[i] * (float)u1[i] + cw2[i] * (float)u0[i];
        y[i] = (float)cbv[i] * acc;
        ss += y[i] * y[i];
      }
      ss = wave_sum(ss);
      const float rs = rsqrtf(ss * (1.f / 512.f) + 1e-6f);
#pragma unroll
      for (int i = 0; i < 8; ++i) oc[i] = y[i] * rs * wcn[i];
    }
    float am = 0.f;
#pragma unroll
    for (int i = 0; i < 8; ++i) am = fmaxf(am, fmaxf(fabsf(oa[i]), fabsf(oc[i])));
    am = fmaxf(wave_max(am), 1e-20f);
    const float inv = 127.f / am;
    uint32_t qa[2] = {0u, 0u}, qc[2] = {0u, 0u};
#pragma unroll
    for (int i = 0; i < 8; ++i) {
      qa[i >> 2] |= (uint32_t)((int)rintf(oa[i] * inv) & 255) << (8 * (i & 3));
      qc[i >> 2] |= (uint32_t)((int)rintf(oc[i] * inv) & 255) << (8 * (i & 3));
    }
    *(uint2*)(p.h8() + (size_t)tok * 1024 + c0) = make_uint2(qa[0], qa[1]);
    *(uint2*)(p.h8() + (size_t)tok * 1024 + 512 + c0) = make_uint2(qc[0], qc[1]);
    if (lane == 0) p.hs1()[tok] = am * (1.f / 127.f);
  }
#undef YM_LOAD
}


#define XB_TMO      128
#define XB_XCNT(j)  (256  + 64 * (j))
#define XB_XSUB(j)  (1280 + 64 * (j))
#define XB_XGEN(j)  (2304 + 64 * (j))
#define XB_TOP      3328
#define XB_TOPGEN   3392
#define XCD_BAR_WORDS 3456
#define XB_SPIN_CAP (1u << 22)
__device__ __forceinline__ unsigned xb_ld(unsigned* p) { return __hip_atomic_load(p, __ATOMIC_RELAXED, __HIP_MEMORY_SCOPE_AGENT); }
__device__ __forceinline__ unsigned xb_add(unsigned* p, unsigned v) { return __hip_atomic_fetch_add(p, v, __ATOMIC_RELAXED, __HIP_MEMORY_SCOPE_AGENT); }
__device__ __forceinline__ unsigned xb_xcc_id() { return (unsigned)__builtin_amdgcn_s_getreg((3 << 11) | 20) & 0xFu; }
#define XB_SPIN(cond, bar) do { unsigned _sp = 0; while (cond) { __builtin_amdgcn_s_sleep(1); \
    if ((++_sp & 255u) == 0u) { if (xb_ld(&(bar)[XB_TMO])) break; if (_sp > XB_SPIN_CAP) { atomicAdd(&(bar)[XB_TMO], 1u); break; } } } } while (0)
__device__ __forceinline__ void xcd_barrier_post(unsigned* bar, volatile LAS unsigned* st) {
  if (TIDX == 0) {
    const unsigned x = xb_xcc_id();
    st[0] = 0u;
    st[1] = 0u;
    st[2] = x;
    st[3] = xb_add(&bar[XB_XCNT(x)], 1u);
  }
}
__device__ __forceinline__ void xcd_barrier_complete(unsigned* bar, unsigned x, unsigned& nloc, unsigned& nx) {
  const unsigned G = gridDim.x * gridDim.y * gridDim.z;
  unsigned sum, cnt, mine, sp = 0u;
  for (;;) {
    sum = 0u; cnt = 0u; mine = 0u;
#pragma unroll
    for (unsigned j = 0; j < 16; ++j) { const unsigned c = xb_ld(&bar[XB_XCNT(j)]); sum += c; cnt += (c > 0u) ? 1u : 0u; mine = (j == x) ? c : mine; }
    if (sum == G) break;
    __builtin_amdgcn_s_sleep(1);
    if ((++sp & 255u) == 0u) { if (xb_ld(&bar[XB_TMO])) break; if (sp > XB_SPIN_CAP) { atomicAdd(&bar[XB_TMO], 1u); break; } }
  }
  nloc = mine > 0u ? mine : 1u;
  nx = cnt > 0u ? cnt : 1u;
}
__device__ __forceinline__ void xcd_barrier(unsigned* bar, volatile LAS unsigned* st) {
  asm volatile("s_waitcnt vmcnt(0)" ::: "memory");
  __syncthreads();
  if (TIDX == 0) {
    __builtin_amdgcn_s_waitcnt(0);
    unsigned nloc = st[0], nx = st[1];
    const unsigned x = st[2];
    if (nloc == 0u) { xcd_barrier_complete(bar, x, nloc, nx); st[0] = nloc; st[1] = nx; }
    const unsigned old = xb_add(&bar[XB_XSUB(x)], 1u);
    const unsigned gen = old / nloc;
    if (old + 1u == (gen + 1u) * nloc) {
      __builtin_amdgcn_fence(__ATOMIC_RELEASE, "agent");
      asm volatile("s_waitcnt vmcnt(0)" ::: "memory");
      const unsigned og = xb_add(&bar[XB_TOP], 1u);
      const unsigned tg = og / nx;
      if (og + 1u == (tg + 1u) * nx) xb_add(&bar[XB_TOPGEN], 1u);
      else XB_SPIN(xb_ld(&bar[XB_TOPGEN]) == tg, bar);
      __builtin_amdgcn_fence(__ATOMIC_ACQUIRE, "agent");
      asm volatile("s_waitcnt vmcnt(0)" ::: "memory");
    } else {
      XB_SPIN(xb_ld(&bar[XB_TOPGEN]) == gen, bar);
      __builtin_amdgcn_fence(__ATOMIC_ACQUIRE, "agent");
      asm volatile("s_waitcnt vmcnt(0)" ::: "memory");
    }
  }
  __syncthreads();
}

struct SliceSched {
  int nloc, rank, myord, npop;
};
__device__ __forceinline__ SliceSched slice_sched(unsigned* bar, volatile LAS unsigned* st) {
  SliceSched r;
  const unsigned x = st[2];
  int npop = 0, myord = 0, nloc = 1;
  for (unsigned j = 0; j < 16; ++j) {
    const unsigned c = xb_ld(&bar[XB_XCNT(j)]);
    if (j == x) {
      myord = npop;
      nloc = (int)c;
    }
    npop += (c > 0u) ? 1 : 0;
  }
  r.nloc = __builtin_amdgcn_readfirstlane(nloc);
  r.rank = __builtin_amdgcn_readfirstlane((int)st[3]);
  r.myord = __builtin_amdgcn_readfirstlane(myord);
  r.npop = __builtin_amdgcn_readfirstlane(npop);
  return r;
}

__device__ __forceinline__ void sort16_desc(uint32_t (&x)[16]) {
  CEX(x[0], x[13]); CEX(x[1], x[12]); CEX(x[2], x[15]); CEX(x[3], x[14]); CEX(x[4], x[8]); CEX(x[5], x[6]); CEX(x[7], x[11]); CEX(x[9], x[10]);
  CEX(x[0], x[5]); CEX(x[1], x[7]); CEX(x[2], x[9]); CEX(x[3], x[4]); CEX(x[6], x[13]); CEX(x[8], x[14]); CEX(x[10], x[15]); CEX(x[11], x[12]);
  CEX(x[0], x[1]); CEX(x[2], x[3]); CEX(x[4], x[5]); CEX(x[6], x[8]); CEX(x[7], x[9]); CEX(x[10], x[11]); CEX(x[12], x[13]); CEX(x[14], x[15]);
  CEX(x[0], x[2]); CEX(x[1], x[3]); CEX(x[4], x[10]); CEX(x[5], x[11]); CEX(x[6], x[7]); CEX(x[8], x[9]); CEX(x[12], x[14]); CEX(x[13], x[15]);
  CEX(x[1], x[2]); CEX(x[3], x[12]); CEX(x[4], x[6]); CEX(x[5], x[7]); CEX(x[8], x[10]); CEX(x[9], x[11]); CEX(x[13], x[14]);
  CEX(x[1], x[4]); CEX(x[2], x[6]); CEX(x[5], x[8]); CEX(x[7], x[10]); CEX(x[9], x[13]); CEX(x[11], x[14]);
  CEX(x[2], x[4]); CEX(x[3], x[6]); CEX(x[9], x[12]); CEX(x[11], x[13]);
  CEX(x[3], x[5]); CEX(x[6], x[8]); CEX(x[7], x[9]); CEX(x[10], x[12]);
  CEX(x[3], x[4]); CEX(x[5], x[6]); CEX(x[7], x[8]); CEX(x[9], x[10]); CEX(x[11], x[12]);
  CEX(x[6], x[7]); CEX(x[8], x[9]);
}
__device__ __forceinline__ void merge16_desc(uint32_t (&t)[16], const uint32_t (&x)[16]) {
#pragma unroll
  for (int i = 0; i < 16; ++i) t[i] = max(t[i], x[15 - i]);
#pragma unroll
  for (int j = 8; j >= 1; j >>= 1) {
#pragma unroll
    for (int i = 0; i < 16; ++i) {
      const int pnr = i ^ j;
      if (pnr > i) CEX(t[i], t[pnr]);
    }
  }
}
__device__ __forceinline__ uint32_t f2key(float f) {
  uint32_t u = __float_as_uint(f);
  return (u & 0x80000000u) ? ~u : (u | 0x80000000u);
}
__device__ __forceinline__ float hkey2f(uint32_t k) {
  const uint32_t c = k >> 16;
  const uint16_t h = (uint16_t)((c & 0x8000u) ? (c ^ 0x8000u) : ~c);
  return (float)__builtin_bit_cast(half_t, h);
}
__device__ __forceinline__ float key2f(uint32_t k) {
  uint32_t u = (k & 0x80000000u) ? (k & 0x7fffffffu) : ~k;
  return __uint_as_float(u);
}

__device__ __forceinline__ void topk_item(const Params& p, uint32_t* mytab, const half_t* row, const int tok, const int hp,
                                          const int lane) {
  {
    uint32_t t[16];
    u32x4 rowv[16];
#pragma unroll
    for (int i = 0; i < 16; ++i) rowv[i] = *(const u32x4*)(row + i * 8);
    __builtin_amdgcn_sched_barrier(0);
#pragma unroll
    for (int grp = 0; grp < 8; ++grp) {
      const u32x4 a = rowv[2 * grp], b = rowv[2 * grp + 1];
      uint32_t x[16];
#pragma unroll
      for (int i = 0; i < 4; ++i) {
        const uint32_t wa = a[i], wb = b[i];
        const uint32_t ka = wa ^ (__builtin_bit_cast(uint32_t, __builtin_bit_cast(s16x2, wa) >> 15) | 0x80008000u);
        const uint32_t kb = wb ^ (__builtin_bit_cast(uint32_t, __builtin_bit_cast(s16x2, wb) >> 15) | 0x80008000u);
        x[2 * i] = (ka << 16) | (uint32_t)(grp * 16 + 2 * i);
        x[2 * i + 1] = (ka & 0xffff0000u) | (uint32_t)(grp * 16 + 2 * i + 1);
        x[8 + 2 * i] = (kb << 16) | (uint32_t)(grp * 16 + 8 + 2 * i);
        x[8 + 2 * i + 1] = (kb & 0xffff0000u) | (uint32_t)(grp * 16 + 8 + 2 * i + 1);
      }
      sort16_desc(x);
      if (grp == 0) {
#pragma unroll
        for (int i = 0; i < 16; ++i) t[i] = x[i];
      } else {
        merge16_desc(t, x);
      }
    }
    const uint32_t hodd = (uint32_t)(lane & 1);
    float va[16], vb[16];
    uint32_t pa[16], pb[16];
#pragma unroll
    for (int i = 0; i < 16; ++i) {
      const uint32_t o = (uint32_t)__builtin_amdgcn_update_dpp(0, (int)t[i], 0xB1, 0xF, 0xF, true);
      va[i] = hkey2f(t[i]);
      vb[i] = hkey2f(o);
      pa[i] = (t[i] & 127u) << (hodd ? 0u : 7u);
      pb[i] = (o & 127u) << (hodd ? 7u : 0u);
    }
    uint32_t c[2][16];
    uint32_t etab[28];
    const uint32_t hs = hodd << 5;
    {
      int slot = 0;
#pragma unroll
      for (int i = 0; i < 16; ++i) {
#pragma unroll
        for (int j = i; j < 16; ++j) {
          if ((i + 1) * (j + 1) <= 16) {
            uint32_t key = (f2key(va[i] + vb[j]) & ~63u) | ((uint32_t)slot | hs);
            if (i == j) key = hodd ? 0u : key;
            c[slot >> 4][slot & 15] = key;
            etab[slot] = pa[i] + pb[j];
            ++slot;
          }
        }
      }
#pragma unroll
      for (; slot < 32; ++slot) {
        c[slot >> 4][slot & 15] = 0u;
        if (slot < 28) etab[slot] = 0u;
      }
    }
    uint32_t* ptab = mytab - 27 * (int)hodd;
#pragma unroll
    for (int s2 = 0; s2 < 14; ++s2) ptab[hodd * 16 + s2] = etab[2 * s2] | (etab[2 * s2 + 1] << 16);
    sort16_desc(c[0]);
    sort16_desc(c[1]);
    merge16_desc(c[0], c[1]);
    {
      uint32_t oth[16];
#pragma unroll
      for (int r = 0; r < 16; ++r) oth[r] = (uint32_t)__builtin_amdgcn_update_dpp(0, (int)c[0][r], 0xB1, 0xF, 0xF, true);
      merge16_desc(c[0], oth);
    }
    float sv[16], den = 0.f;
    const float mx = key2f(c[0][0] & ~63u);
#pragma unroll
    for (int r = 0; r < 16; ++r) {
      sv[r] = __expf(key2f(c[0][r] & ~63u) - mx);
      den += sv[r];
    }
    const float rden = 1.f / den;
    if ((lane & 1) == 0) {
      const int head = hp >> 1;
      uint32_t ew[8];
      f32x4 gv[4];
#pragma unroll
      for (int r = 0; r < 16; ++r) {
        const uint32_t slot = c[0][r] & 63u;
        const uint32_t pr = ptab[slot >> 1];
        const uint32_t e16 = (slot & 1) ? (pr >> 16) : (pr & 0xffffu);
        if (r & 1) ew[r >> 1] |= e16 << 16;
        else ew[r >> 1] = e16;
        gv[r >> 2][r & 3] = sv[r] * rden;
      }
      u32x4* eo = (u32x4*)(p.eid() + (size_t)tok * 128 + head * 16);
      u32x4* go = (u32x4*)((uint32_t*)p.gw() + (size_t)tok * 128 + head * 16);
      float usr[16];
#pragma unroll
      for (int r = 0; r < 16; ++r) usr[r] = p.uscale()[(r & 1) ? (ew[r >> 1] >> 16) : (ew[r >> 1] & 0xffffu)];
      eo[0] = (u32x4){ew[0], ew[1], ew[2], ew[3]};
      eo[1] = (u32x4){ew[4], ew[5], ew[6], ew[7]};
#pragma unroll
      for (int q = 0; q < 4; ++q) {
        u32x4 w;
#pragma unroll
        for (int i = 0; i < 4; ++i) {
          const half_t hg = (half_t)gv[q][i], hu = (half_t)usr[4 * q + i];
          w[i] = (uint32_t)__builtin_bit_cast(uint16_t, hg) | ((uint32_t)__builtin_bit_cast(uint16_t, hu) << 16);
        }
        go[q] = w;
      }
    }
  }
}

__device__ __forceinline__ float gelu_tanh(float x) {
  const float z = 0.7978845608028654f * (x + 0.044715f * x * x * x);
  const float e = __expf(2.f * z);
  const float th = 1.f - 2.f / (e + 1.f);
  return 0.5f * x * (1.f + th);
}

__device__ __forceinline__ int red8_dpp(int v) {
  v += __builtin_amdgcn_update_dpp(0, v, 0x141, 0xF, 0xF, true);
  v += __builtin_amdgcn_update_dpp(0, v, 0xB1, 0xF, 0xF, true);
  v += __builtin_amdgcn_update_dpp(0, v, 0x4E, 0xF, 0xF, true);
  return v;
}

#define PU_WDW 1032
#define PU_ISSUE(S, SLOT, NN, BB, TOKV)                                                              \
  {                                                                                                  \
    const int idx_ = (BB) * 8 + grp;                                                                 \
    val##S = idx_ < (NN);                                                                            \
    const uint32_t ent_ = val##S ? lst[(SLOT) * 128 + idx_] : 0u;                                    \
    {                                                                                                \
      const uint32_t gu_ = val##S ? lstg[(SLOT) * 128 + idx_] : 0u;                                  \
      gg##S = (float)__builtin_bit_cast(half_t, (uint16_t)(gu_ & 0xffffu));                          \
      us##S = (float)__builtin_bit_cast(half_t, (uint16_t)(gu_ >> 16));                              \
    }                                                                                                \
    const uint32_t e_ = ent_ & 0xffffu;                                                              \
    cp##S = val##S ? (p.coefh() + (size_t)(TOKV) * 128 + (ent_ >> 16)) : dummy;                      \
      \
    const unsigned ro_ = val##S ? ((e_ >> 3) * 1024u + (unsigned)sub * 16u) : 0xFFFFF000u;           \
    _Pragma("unroll") for (int st = 0; st < 8; ++st)                                                 \
      w##S[st] = __builtin_amdgcn_raw_buffer_load_b128(urs, (int)(ro_ + st * 128u), 0, 0);           \
  }
#define PU_FIN(S)                                                                                    \
  {                                                                                                  \
    int d = 0;                                                                                       \
    _Pragma("unroll") for (int st = 0; st < 8; ++st)                                                 \
      _Pragma("unroll") for (int c = 0; c < 4; ++c)                                                  \
        d = __builtin_amdgcn_sdot4((int)w##S[st][c], (int)hqC[st][c], d, false);                     \
    d = red8_dpp(d);                                                                                 \
    *cp##S = (half_t)(gg##S * gelu_tanh((float)d * us##S * hsC));                                    \
  }
#define PU_STAGE(SLOT, NOUT)                                                                         \
  {                                                                                                  \
    const bool ina_ = (m_ea & 7u) == (uint32_t)x, inb_ = (m_eb & 7u) == (uint32_t)x;                 \
    const unsigned long long ba_ = __ballot(ina_), bb_ = __ballot(inb_);                             \
    const int ca_ = __popcll(ba_);                                                                   \
    NOUT = ca_ + __popcll(bb_);                                                                      \
    if (ina_) {                                                                                      \
      const int q_ = (SLOT) * 128 + __popcll(ba_ & lmask);                                           \
      lst[q_] = m_ea | ((uint32_t)lane << 16);                                                       \
      lstg[q_] = m_ga;                                                                               \
    }                                                                                                \
    if (inb_) {                                                                                      \
      const int q_ = (SLOT) * 128 + ca_ + __popcll(bb_ & lmask);                                     \
      lst[q_] = m_eb | ((uint32_t)(64 + lane) << 16);                                                \
      lstg[q_] = m_gb;                                                                               \
    }                                                                                                \
    *(u32x4*)(hrow + (SLOT) * 256 + lane * 4) = m_h;                                                 \
    if (lane == 0) hsv[SLOT] = m_hs;                                                                 \
    asm volatile("s_waitcnt lgkmcnt(0)" ::: "memory");                                              \
  }
#define PU_TOK(i) (tok0 + min((i), ntok - 1) * tstride)
#define PU_FETCH(TI)                                                                                 \
  {                                                                                                  \
    const int t_ = PU_TOK(TI);                                                                       \
    m_ea = p.eid()[(size_t)t_ * 128 + lane];                                                         \
    m_eb = p.eid()[(size_t)t_ * 128 + 64 + lane];                                                    \
    m_ga = ((const uint32_t*)p.gw())[(size_t)t_ * 128 + lane];        \
    m_gb = ((const uint32_t*)p.gw())[(size_t)t_ * 128 + 64 + lane];                                  \
    m_h = *(const u32x4*)(p.h2q() + (size_t)t_ * 1024 + lane * 16);                                  \
    m_hs = p.hscale()[t_];                                                                           \
  }
#define PU_LOADH(SLOT)                                                                               \
  {                                                                                                  \
    _Pragma("unroll") for (int st = 0; st < 8; ++st) hqC[st] = *(const u32x4*)(hrow + (SLOT) * 256 + st * 32 + sub * 4); \
    hsC = hsv[SLOT];                                                                                 \
  }
#define PU_TOKEN(TI, SL, X, Y)                                                                       \
  {                                                                                                  \
    const int tokC = PU_TOK(TI), tokN = PU_TOK((TI) + 1);                                            \
    PU_STAGE((SL) ^ 1, n_nxt);                                                                       \
    PU_FETCH((TI) + 2)                                                                               \
    PU_ISSUE(Y, SL, n_cur, 1, tokC)                                                                  \
    PU_FIN(X)                                                                                        \
    PU_ISSUE(X, SL, n_cur, 2, tokC)                                                                  \
    PU_FIN(Y)                                                                                        \
    PU_ISSUE(Y, (SL) ^ 1, n_nxt, 0, tokN)                                                            \
    PU_FIN(X)                                                                                        \
    for (int bx = 3; bx * 8 < n_cur; ++bx) {                                                         \
      PU_ISSUE(X, SL, n_cur, bx, tokC)                                                               \
      PU_FIN(X)                                                                                      \
    }                                                                                                \
    PU_LOADH((SL) ^ 1)                                                                               \
    n_cur = n_nxt;                                                                                   \
  }
__device__ __forceinline__ void phase_peer_u(const Params& p, uint32_t* sm, const int x, const int rank, const int nper) {
  const int lane = TIDX & 63, wave = TIDX >> 6;
  const int grp = lane >> 3, sub = lane & 7;
  uint32_t* lst = sm + wave * PU_WDW;
  uint32_t* lstg = lst + 256;
  uint32_t* hrow = lst + 512;
  float* hsv = (float*)(lst + 1024);
  const unsigned long long ubase_ = (unsigned long long)(p.pu8() + (size_t)x * 2048 * 1024);
  const unsigned ub_lo = (unsigned)__builtin_amdgcn_readfirstlane((int)(unsigned)ubase_);
  const unsigned ub_hi = (unsigned)__builtin_amdgcn_readfirstlane((int)(unsigned)(ubase_ >> 32));
  const __amdgpu_buffer_rsrc_t urs =
      __builtin_amdgcn_make_buffer_rsrc((void*)(((unsigned long long)ub_hi << 32) | ub_lo), 0, 2048 * 1024, 0x00020000);
  const unsigned long long lmask = (1ull << lane) - 1ull;
  const int tstride = nper * NWAVE;
  const int tok0 = rank * NWAVE + wave;
  if (tok0 >= T_TOK) return;
  const int ntok = (T_TOK - tok0 + tstride - 1) / tstride;
  half_t* dummy = (half_t*)p.v() + ((size_t)blockIdx.x * NTHR + TIDX) * 2;
  u32x4 wA[8], wB[8];
  bool valA = false, valB = false;
  half_t* cpA = dummy;
  half_t* cpB = dummy;
  float usA = 0.f, usB = 0.f, ggA = 0.f, ggB = 0.f;
  u32x4 hqC[8];
  float hsC;
  uint32_t m_ea, m_eb;
  uint32_t m_ga, m_gb;
  float m_hs;
  u32x4 m_h;
  int n_cur, n_nxt = 0;
  PU_FETCH(0)
  PU_STAGE(0, n_cur);
  PU_FETCH(1)
  PU_LOADH(0)
  PU_ISSUE(A, 0, n_cur, 0, tok0)
  asm volatile("s_waitcnt vmcnt(0)" ::: "memory");
#pragma unroll 1
  for (int ti = 0; ti < ntok; ti += 2) {
    PU_TOKEN(ti, 0, A, B)
    PU_TOKEN(ti + 1, 1, B, A)
  }
}
#undef PU_ISSUE
#undef PU_FIN
#undef PU_STAGE
#undef PU_FETCH
#undef PU_LOADH
#undef PU_TOKEN
#undef PU_TOK

__device__ __forceinline__ void phase_peer_v(const Params& p, const int x, const int rank, const int nper) {
  typedef unsigned u32x2 __attribute__((ext_vector_type(2)));
  const int lane = TIDX & 63, wave = TIDX >> 6;
  const int pg = lane >> 3, ch = lane & 7;
  const unsigned long long vbase_ = (unsigned long long)(p.pv8() + (size_t)x * 16384 * 128);
  const unsigned vb_lo = (unsigned)__builtin_amdgcn_readfirstlane((int)(unsigned)vbase_);
  const unsigned vb_hi = (unsigned)__builtin_amdgcn_readfirstlane((int)(unsigned)(vbase_ >> 32));
  const __amdgpu_buffer_rsrc_t vrs =
      __builtin_amdgcn_make_buffer_rsrc((void*)(((unsigned long long)vb_hi << 32) | vb_lo), 0, 16384 * 128, 0x00020000);
  const unsigned vch = (unsigned)ch * 16u;
  const int tstride = nper * NWAVE;
  const int tok0 = rank * NWAVE + wave;
  if (tok0 >= T_TOK) return;
  const int ntok = (T_TOK - tok0 + tstride - 1) / tstride;
  const int dd = x * 128 + ch * 16 + 4 * ((lane >> 4) & 1) + 8 * (lane >> 5);
  float* dummy = (float*)p.v() + ((size_t)blockIdx.x * NTHR + TIDX) * 4;
#define PV_TOK(i) (tok0 + min((i), ntok - 1) * tstride)
#define PV_LOAD_IDS(E, i)                                                              \
  {                                                                                    \
    const u32x4* ep = (const u32x4*)(p.eid() + (size_t)PV_TOK(i) * 128 + pg * 16);     \
    E[0] = ep[0];                                                                      \
    E[1] = ep[1];                                                                      \
  }
#define PV_LOAD_COEF(C, i)                                                             \
  {                                                                                    \
    const half8* cp = (const half8*)(p.coefh() + (size_t)PV_TOK(i) * 128 + pg * 16);   \
    C[0] = cp[0];           \
    C[1] = cp[1];                                                                      \
  }
#define PV_ROWS(W, E)                                                                  \
  _Pragma("unroll") for (int it = 0; it < 16; ++it) {                                  \
    const uint32_t e = (E[it >> 3][(it >> 1) & 3] >> (16 * (it & 1))) & 0xffffu;       \
    W[it] = __builtin_amdgcn_raw_buffer_load_b128(vrs, (int)((e << 7) | vch), 0, 0);   \
  }
#define PV_STEP(I, WC, EC, CC, WN, EN)                                                                                 \
  {                                                                                                                    \
    const int tok = PV_TOK(I);                                                                                         \
    PV_LOAD_IDS(EC, (I) + 2)                                                                                           \
    float* op = p.out + (size_t)tok * 1024 + dd;                                                                       \
    const half4 x1 = *(const half4*)(p.x1h() + (size_t)tok * 1024 + dd);                                               \
    const f32x4 gt = *(const f32x4*)(p.mod() + (tok >> 13) * 6144 + 5120 + dd);                                       \
    __builtin_amdgcn_sched_barrier(0);     \
    PV_ROWS(WN, EN)                                                                                                    \
    __builtin_amdgcn_sched_barrier(0);                                                                                 \
    f32x2 acc[8];                                                                                                      \
    _Pragma("unroll") for (int i = 0; i < 8; ++i) acc[i] = (f32x2){0.f, 0.f};                                          \
    _Pragma("unroll") for (int it = 0; it < 16; ++it) {                                                                \
      const float cfi = (float)CC[it >> 3][it & 7];                                                                    \
      const f32x2 c2 = (f32x2){cfi, cfi};                                                                              \
      _Pragma("unroll") for (int d = 0; d < 4; ++d) {                                                                  \
        const f32x2 lo = __builtin_amdgcn_cvt_pk_f32_fp8((int)WC[it][d], false);                                       \
        const f32x2 hi = __builtin_amdgcn_cvt_pk_f32_fp8((int)WC[it][d], true);                                        \
        acc[d * 2 + 0] += c2 * lo;                                                                                     \
        acc[d * 2 + 1] += c2 * hi;                                                                                     \
      }                                                                                                                \
    }                                                                                                                  \
             \
    float a16[16];                                                                                                     \
    _Pragma("unroll") for (int i = 0; i < 8; ++i) {                                                                    \
      a16[2 * i] = acc[i][0];                                                                                          \
      a16[2 * i + 1] = acc[i][1];                                                                                      \
    }                                                                                                                  \
    float s1[8];                                                                                                       \
    _Pragma("unroll") for (int i = 0; i < 8; ++i) {                                                                    \
      const u32x2 r = __builtin_amdgcn_permlane32_swap(__float_as_uint(a16[i]), __float_as_uint(a16[i + 8]), false, false); \
      s1[i] = __uint_as_float(r[0]) + __uint_as_float(r[1]);            \
    }                                                                                                                  \
    float s2[4];                                                                                                       \
    _Pragma("unroll") for (int i = 0; i < 4; ++i) {                                                                    \
      const u32x2 r = __builtin_amdgcn_permlane16_swap(__float_as_uint(s1[i]), __float_as_uint(s1[i + 4]), false, false); \
      s2[i] = __uint_as_float(r[0]) + __uint_as_float(r[1]);      \
    }                                                                                                                  \
    f32x4 o;                                                                                                           \
    _Pragma("unroll") for (int i = 0; i < 4; ++i) {                                                                    \
      const float t8 = __uint_as_float((unsigned)__builtin_amdgcn_update_dpp(0, (int)__float_as_uint(s2[i]), 0x128, 0xF, 0xF, true)); \
      o[i] = (float)x1[i] + gt[i] * (s2[i] + t8) * (1.f / 128.f);                                                      \
    }                                                                                                                  \
      \
    *(f32x4*)(((I) < ntok) ? op : dummy) = o;                                                                          \
    PV_LOAD_COEF(CC, (I) + 2)                                                                                          \
  }
  u32x4 eA[2], eB[2], wA[16], wB[16];
  half8 cA[2], cB[2];
  PV_LOAD_IDS(eA, 0)
  PV_LOAD_COEF(cA, 0)
  PV_LOAD_IDS(eB, 1)
  PV_LOAD_COEF(cB, 1)
  PV_ROWS(wA, eA)
  asm volatile("s_waitcnt vmcnt(0)" ::: "memory");
#pragma unroll 1
  for (int i = 0; i < ntok; i += 2) {
    PV_STEP(i, wA, eA, cA, wB, eB)
    PV_STEP(i + 1, wB, eB, cB, wA, eA)
  }
#undef PV_TOK
#undef PV_LOAD_IDS
#undef PV_LOAD_COEF
#undef PV_ROWS
#undef PV_STEP
}

namespace cg = cooperative_groups;
__global__ __launch_bounds__(NTHR) void fwd_megakernel(Params p) {
  __shared__ __attribute__((aligned(16))) char smem[131072 + 32];
#define xb_words (*(uint4*)(smem + 131072))
  cg::grid_group grid = cg::this_grid();
  xcd_barrier_post(p.bar(), (volatile LAS unsigned*)&xb_words);
  __syncthreads();
  const int bid = blockIdx.x, nblk = gridDim.x;
  float* smf = (float*)smem;
  half_t* smh = (half_t*)smem;
  prep_ada(p, smf, bid, nblk);
  __syncthreads();
  prep_transpose<true>(p.w_in, p.wt_in(), DIN, DINP, smf, bid, nblk);
  prep_wprime(p, smf, bid, nblk);
  prep_transpose<false>(p.w_out, p.wt_out(), 1024, 1024, smf, bid, nblk);
  if (p.ws == nullptr) grid.sync();
  xcd_barrier(p.bar(), (volatile LAS unsigned*)&xb_words);
  quant_rows(p, bid, nblk);
  phase_norm_mod<true, false>(p.x, p.norm1_w, p.mod(), 0, 1024, nullptr, p.h8(), p.hs1(), bid, nblk);
  xcd_barrier(p.bar(), (volatile LAS unsigned*)&xb_words);
  {
    const int rem = (128 * 15) % nblk;
    const bool light = (rem != 0) && (bid >= rem);
    if (light) prep_tables(p, bid - rem, nblk - rem, 0);
    {
      EpiIn e{p};
      phase_gemm<EpiIn, 15>(p.h(), p.wt_in(), 15, smh, e, bid, nblk);
    }
    if (rem == 0) {
      prep_tables(p, bid, nblk, 0);
      prep_tables(p, bid, nblk, 1);
    } else if (light) {
      prep_tables(p, bid - rem, nblk - rem, 1);
    }
  }
  xcd_barrier(p.bar(), (volatile LAS unsigned*)&xb_words);
  phase_index(p, smh, bid, nblk);
  xcd_barrier(p.bar(), (volatile LAS unsigned*)&xb_words);
  phase_attn(p, smem, bid, nblk);
  xcd_barrier(p.bar(), (volatile LAS unsigned*)&xb_words);
  phase_ymix(p, bid, nblk);
  xcd_barrier(p.bar(), (volatile LAS unsigned*)&xb_words);
  {
    EpiOut e{p};
    phase_gemm<EpiOut, 4>(p.ymix(), p.wt_out(), 4, smh, e, bid, nblk);
  }
  xcd_barrier(p.bar(), (volatile LAS unsigned*)&xb_words);
  phase_norm_mod<true, true>(p.x1h(), p.norm2_w, p.mod(), 3072, 4096, nullptr, p.h2q(), p.hscale(), bid, nblk);
  xcd_barrier(p.bar(), (volatile LAS unsigned*)&xb_words);
  {
    EpiPs e{p, p.ps() + (size_t)bid * 65536};
    phase_gemm<EpiPs, 8>(p.h2(), p.wt_p(), 8, smh, e, bid, nblk);
  }
  xcd_barrier(p.bar(), (volatile LAS unsigned*)&xb_words);
  const SliceSched ss = slice_sched(p.bar(), (volatile LAS unsigned*)&xb_words);
  for (int sl = ss.myord; sl < 8; sl += ss.npop) phase_peer_u(p, (uint32_t*)smem, sl, ss.rank, ss.nloc);
  xcd_barrier(p.bar(), (volatile LAS unsigned*)&xb_words);
  for (int sl = ss.myord; sl < 8; sl += ss.npop) phase_peer_v(p, sl, ss.rank, ss.nloc);
}

extern "C" void kernel_launch(void* const* d_in, const int* in_sizes, int n_in, void* d_out, int out_size, void* d_ws,
                              size_t ws_size, hipStream_t stream) {
  Params p{};
  p.x = (const float*)d_in[0];
  p.c = (const float*)d_in[1];
  p.norm1_w = (const float*)d_in[2];
  p.norm2_w = (const float*)d_in[3];
  p.w_ada = (const float*)d_in[4];
  p.b_ada = (const float*)d_in[5];
  p.w_in = (const float*)d_in[6];
  p.q_norm_w = (const float*)d_in[7];
  p.k_norm_w = (const float*)d_in[8];
  p.conv_w = (const float*)d_in[9];
  p.conv_b = (const float*)d_in[10];
  p.attn_out_norm_w = (const float*)d_in[11];
  p.conv_out_norm_w = (const float*)d_in[12];
  p.w_out = (const float*)d_in[13];
  p.peer_wq = (const float*)d_in[14];
  p.peer_subkeys = (const float*)d_in[15];
  p.peer_u = (const float*)d_in[16];
  p.peer_v = (const float*)d_in[17];
  p.out = (float*)d_out;
  p.ws = (char*)d_ws;
  (void)ws_size;
  (void)in_sizes;
  (void)n_in;
  (void)out_size;

  static int grid_blocks = 0;
  if (!grid_blocks) {
    int dev = 0, cus = 0, per_cu = 0;
    hipGetDevice(&dev);
    hipDeviceGetAttribute(&cus, hipDeviceAttributeMultiprocessorCount, dev);
    hipOccupancyMaxActiveBlocksPerMultiprocessor(&per_cu, fwd_megakernel, NTHR, 0);
    if (per_cu < 1) per_cu = 1;
    grid_blocks = cus * per_cu;
  }
  hipMemsetAsync(p.bar(), 0, XCD_BAR_WORDS * 4, stream);
  void* args[] = {&p};
  hipLaunchCooperativeKernel((void*)fwd_megakernel, dim3(grid_blocks), dim3(NTHR), args, 0, stream);
}
```
